# Optimizing an MI355X kernel written in HIP

```python
import math
import jax
import jax.numpy as jnp
from jax import lax
import numpy as np

D_MODEL = 1024
BATCH = 4
SEQ = 4096
DEPTH = 1

CTX_LEN = 256
GRID_W = 64
SSM_CH_PER_GROUP = 16
SSM_GROUPS = 32
SSM_WIDTH = SSM_GROUPS * SSM_CH_PER_GROUP
SSM_STATE = 64
SSM_DT_MIN = 1e-3
SSM_DT_MAX = 1e-1
HEAD_DIM = 64
N_Q_HEADS = 8
N_KV_HEADS = 2
Q_PER_KV = N_Q_HEADS // N_KV_HEADS
ATTN_WIDTH = N_Q_HEADS * HEAD_DIM
KV_WIDTH = N_KV_HEADS * HEAD_DIM
WINDOW = 128
ATTN_BLOCK = WINDOW
ROPE_BASE = 10000.0
ROPE_PAIRS_PER_AXIS = HEAD_DIM // 4
IN_COLS = SSM_WIDTH + ATTN_WIDTH + 2 * KV_WIDTH + 2 * D_MODEL
N_EXPERTS = 32
TOP_K = 4
D_EXPERT = D_MODEL
SWIGLU_LIMIT = 7.0
SWIGLU_ALPHA = 1.702
MOE_BLOCK = 128
LN_EPS = 1e-5
DEEPNORM_ALPHA = (2 * DEPTH) ** 0.25
DEEPNORM_BETA = (8 * DEPTH) ** -0.25
NEG_INF = -1e30

kernel_name = 'hybrid_s5_swa_moe_prefix_layer'


def layer_norm(x, g, b):
    xf = x.astype(jnp.float32)
    mu = xf.mean(-1, keepdims=True)
    var = jnp.square(xf - mu).mean(-1, keepdims=True)
    y = (xf - mu) * lax.rsqrt(var + LN_EPS) * g.astype(jnp.float32) + b.astype(jnp.float32)
    return y.astype(x.dtype)


def modulate(x, shift, scale):
    return x * (1 + scale) + shift


def split_proj(p):
    i0 = SSM_WIDTH
    i1 = i0 + ATTN_WIDTH
    i2 = i1 + KV_WIDTH
    i3 = i2 + KV_WIDTH
    i4 = i3 + D_MODEL
    return jnp.split(p, [i0, i1, i2, i3, i4], axis=-1)


def to_heads(t, n_heads):
    return t.reshape(t.shape[:-1] + (n_heads, HEAD_DIM))


def to_groups(t):
    return t.reshape(t.shape[:-1] + (SSM_GROUPS, SSM_CH_PER_GROUP))


def rope_2d(x, row_ids, col_ids):
    inv = ROPE_BASE ** (-jnp.arange(ROPE_PAIRS_PER_AXIS, dtype=jnp.float32) / ROPE_PAIRS_PER_AXIS)
    ang = jnp.concatenate([row_ids.astype(jnp.float32)[:, None] * inv,
                           col_ids.astype(jnp.float32)[:, None] * inv], axis=-1)
    cos = jnp.cos(ang)[None, :, None, :].astype(x.dtype)
    sin = jnp.sin(ang)[None, :, None, :].astype(x.dtype)
    x1, x2 = jnp.split(x, 2, axis=-1)
    return jnp.concatenate([x1 * cos - x2 * sin, x2 * cos + x1 * sin], axis=-1)


def cplx_combine(e1, e2):
    a1r, a1i, b1r, b1i = e1
    a2r, a2i, b2r, b2i = e2
    return (a2r * a1r - a2i * a1i,
            a2r * a1i + a2i * a1r,
            a2r * b1r - a2i * b1i + b2r,
            a2r * b1i + a2i * b1r + b2i)


def s5_discretize(lam_re, lam_im, log_step, b_re, b_im):
    f32 = jnp.float32
    lr, li = lam_re.astype(f32), lam_im.astype(f32)
    dt = jnp.exp(log_step.astype(f32))[:, None]
    mag = jnp.exp(lr * dt)
    ar = mag * jnp.cos(li * dt)
    ai = mag * jnp.sin(li * dt)
    den = lr * lr + li * li
    cr = ((ar - 1) * lr + ai * li) / den
    ci = (ai * lr - (ar - 1) * li) / den
    br, bi = b_re.astype(f32), b_im.astype(f32)
    bbr = cr[..., None] * br - ci[..., None] * bi
    bbi = cr[..., None] * bi + ci[..., None] * br
    return ar, ai, bbr, bbi


def s5_scan(u, disc, s0r, s0i, reverse):
    ar, ai, bbr, bbi = disc
    uf = u.astype(jnp.float32)
    xr = jnp.einsum('blgh,gph->blgp', uf, bbr)
    xi = jnp.einsum('blgh,gph->blgp', uf, bbi)
    edge = u.shape[1] - 1 if reverse else 0
    xr = xr.at[:, edge].add(ar * s0r - ai * s0i)
    xi = xi.at[:, edge].add(ar * s0i + ai * s0r)
    shape = (1, u.shape[1]) + ar.shape
    _, _, sr, si = lax.associative_scan(
        cplx_combine, (jnp.broadcast_to(ar, shape), jnp.broadcast_to(ai, shape), xr, xi),
        reverse=reverse, axis=1)
    return sr, si


def s5_readout(u, sf, sb, c_re, c_im, d_skip):
    cr = c_re.astype(jnp.float32)
    ci = c_im.astype(jnp.float32)
    y = (jnp.einsum('blgp,ghp->blgh', sf[0], cr[0]) - jnp.einsum('blgp,ghp->blgh', sf[1], ci[0])
         + jnp.einsum('blgp,ghp->blgh', sb[0], cr[1]) - jnp.einsum('blgp,ghp->blgh', sb[1], ci[1])
         + d_skip.astype(jnp.float32) * u.astype(jnp.float32))
    return y.reshape(u.shape[:2] + (SSM_WIDTH,)).astype(u.dtype)


def window_attention(q, k, v, kc, vc, sink):
    bsz, seq_len = q.shape[:2]
    n_ctx = kc.shape[1]
    nb = seq_len // ATTN_BLOCK
    qb = q.reshape(bsz, nb, ATTN_BLOCK, N_KV_HEADS, Q_PER_KV, HEAD_DIM) * HEAD_DIM ** -0.5
    pad = ((0, 0), (ATTN_BLOCK, ATTN_BLOCK), (0, 0), (0, 0))

    def band(t):
        tp = jnp.pad(t, pad).reshape(bsz, nb + 2, ATTN_BLOCK, N_KV_HEADS, HEAD_DIM)
        return jnp.concatenate([tp[:, :-2], tp[:, 1:-1], tp[:, 2:]], axis=2)

    kb, vb = band(k), band(v)
    s_loc = jnp.einsum('bnqhgd,bnkhd->bhgnqk', qb, kb).astype(jnp.float32)
    s_ctx = jnp.einsum('bnqhgd,bchd->bhgnqc', qb, kc).astype(jnp.float32)
    blk = jnp.arange(nb)[:, None, None]
    qpos = blk * ATTN_BLOCK + jnp.arange(ATTN_BLOCK)[None, :, None]
    kpos = (blk - 1) * ATTN_BLOCK + jnp.arange(3 * ATTN_BLOCK)[None, None, :]
    valid = (jnp.abs(kpos - qpos) <= WINDOW) & (kpos >= 0) & (kpos < seq_len)
    s_loc = jnp.where(valid, s_loc, NEG_INF)
    snk = sink.astype(jnp.float32).reshape(N_KV_HEADS, Q_PER_KV)[None, :, :, None, None, None]
    snk = jnp.broadcast_to(snk, s_loc.shape[:-1] + (1,))
    p = jax.nn.softmax(jnp.concatenate([s_loc, s_ctx, snk], axis=-1), axis=-1).astype(v.dtype)
    p_loc = p[..., :3 * ATTN_BLOCK]
    p_ctx = p[..., 3 * ATTN_BLOCK:3 * ATTN_BLOCK + n_ctx]
    o = (jnp.einsum('bhgnqk,bnkhd->bnqhgd', p_loc, vb)
         + jnp.einsum('bhgnqc,bchd->bnqhgd', p_ctx, vc))
    return o.reshape(bsz, seq_len, ATTN_WIDTH)


def context_attention(q, k, v, sink):
    bsz, n_ctx = q.shape[:2]
    qg = q.reshape(bsz, n_ctx, N_KV_HEADS, Q_PER_KV, HEAD_DIM) * HEAD_DIM ** -0.5
    s = jnp.einsum('bqhgd,bkhd->bhgqk', qg, k).astype(jnp.float32)
    snk = sink.astype(jnp.float32).reshape(N_KV_HEADS, Q_PER_KV)[None, :, :, None, None]
    snk = jnp.broadcast_to(snk, s.shape[:-1] + (1,))
    p = jax.nn.softmax(jnp.concatenate([s, snk], axis=-1), axis=-1)[..., :n_ctx].astype(v.dtype)
    o = jnp.einsum('bhgqk,bkhd->bqhgd', p, v)
    return o.reshape(bsz, n_ctx, ATTN_WIDTH)


def merge_branches(y_ssm, o_att, g_ssm, g_att, w_glu, b_glu, w_ssm_out, w_att_out, w_o):
    z = jax.nn.gelu(y_ssm)
    z = z * jax.nn.sigmoid(z @ w_glu + b_glu)
    m = jax.nn.sigmoid(g_ssm) * (z @ w_ssm_out) + jax.nn.sigmoid(g_att) * (o_att @ w_att_out)
    return m @ w_o


def moe_ffn(h, w_router, b_router, w_gate_up, b_gate_up, w_down, b_down):
    bsz, n_tok, d = h.shape
    t = bsz * n_tok
    xf = h.reshape(t, d)
    logits = (xf @ w_router + b_router).astype(jnp.float32)
    top_v, top_i = lax.top_k(logits, TOP_K)
    gates = jax.nn.softmax(top_v, axis=-1).astype(h.dtype)
    n_rows = t * TOP_K
    e_flat = top_i.reshape(n_rows)
    tok_flat = jnp.arange(n_rows, dtype=jnp.int32) // TOP_K
    order = jnp.argsort(e_flat)
    e_sorted = e_flat[order]
    counts = jnp.bincount(e_flat, length=N_EXPERTS)
    padded = (counts + MOE_BLOCK - 1) // MOE_BLOCK * MOE_BLOCK
    start = jnp.cumsum(counts) - counts
    pad_end = jnp.cumsum(padded)
    pad_start = pad_end - padded
    dest = pad_start[e_sorted] + jnp.arange(n_rows) - start[e_sorted]
    cap = n_rows + N_EXPERTS * MOE_BLOCK
    n_blocks = cap // MOE_BLOCK
    row_tok = jnp.full((cap,), t, jnp.int32).at[dest].set(tok_flat[order])
    row_gate = jnp.zeros((cap,), h.dtype).at[dest].set(gates.reshape(n_rows)[order])
    block_exp = jnp.minimum(
        jnp.searchsorted(pad_end, jnp.arange(n_blocks) * MOE_BLOCK, side='right'), N_EXPERTS - 1)
    x_rows = jnp.concatenate([xf, jnp.zeros((1, d), h.dtype)], axis=0)[row_tok]
    x_rows = x_rows.reshape(n_blocks, MOE_BLOCK, d)

    def expert_block(args):
        xb, e = args
        gu = xb @ w_gate_up[e] + b_gate_up[e]
        glu, lin = jnp.split(gu, 2, axis=-1)
        glu = jnp.minimum(glu, SWIGLU_LIMIT)
        lin = jnp.clip(lin, -SWIGLU_LIMIT, SWIGLU_LIMIT)
        act = glu * jax.nn.sigmoid(SWIGLU_ALPHA * glu) * (lin + 1)
        return act @ w_down[e] + b_down[e]

    y_rows = lax.map(expert_block, (x_rows, block_exp)).reshape(cap, d)
    y = jnp.zeros((t + 1, d), h.dtype).at[row_tok].add(y_rows * row_gate[:, None])
    return y[:t].reshape(bsz, n_tok, d)


def setup_inputs(seed: int = 0) -> dict:
    key = jax.random.key(seed)
    ks = jax.random.split(key, 36)
    f32 = jnp.float32

    def nrm(i, shape, scale):
        return scale * jax.random.normal(ks[i], shape, f32)

    G, P, H, E, F = SSM_GROUPS, SSM_STATE, SSM_CH_PER_GROUP, N_EXPERTS, D_EXPERT
    n_idx = jnp.arange(P, dtype=f32)
    return {
        'x': nrm(0, (BATCH, SEQ, D_MODEL), 1.0),
        'c': nrm(1, (BATCH, D_MODEL), 1.0),
        'ctx': nrm(2, (BATCH, CTX_LEN, D_MODEL), 1.0),
        'c_ctx': nrm(3, (D_MODEL,), 1.0),
        'ln_in_g': 1.0 + nrm(4, (D_MODEL,), 0.02),
        'ln_in_b': nrm(5, (D_MODEL,), 0.02),
        'w_mod': nrm(6, (DEPTH, D_MODEL, 6 * D_MODEL), 0.5 * D_MODEL ** -0.5),
        'b_mod': nrm(7, (DEPTH, 6 * D_MODEL), 0.02),
        'w_in': nrm(8, (DEPTH, D_MODEL, IN_COLS), D_MODEL ** -0.5),
        'ssm_lam_re': -0.5 + nrm(9, (DEPTH, 2, G, P), 0.01),
        'ssm_lam_im': math.pi * n_idx + nrm(10, (DEPTH, 2, G, P), 0.01),
        'ssm_log_step': jax.random.uniform(ks[11], (DEPTH, 2, G), f32,
                                           minval=math.log(SSM_DT_MIN), maxval=math.log(SSM_DT_MAX)),
        'ssm_b_re': nrm(12, (DEPTH, 2, G, P, H), (2 * H) ** -0.5),
        'ssm_b_im': nrm(13, (DEPTH, 2, G, P, H), (2 * H) ** -0.5),
        'ssm_c_re': nrm(14, (DEPTH, 2, G, H, P), (2 * P) ** -0.5),
        'ssm_c_im': nrm(15, (DEPTH, 2, G, H, P), (2 * P) ** -0.5),
        'ssm_d': nrm(16, (DEPTH, G, H), 1.0),
        'w_glu': nrm(17, (DEPTH, SSM_WIDTH, SSM_WIDTH), SSM_WIDTH ** -0.5),
        'b_glu': nrm(18, (DEPTH, SSM_WIDTH), 0.02),
        'attn_sink': nrm(19, (DEPTH, N_Q_HEADS), 0.5),
        'w_ssm_out': nrm(20, (DEPTH, SSM_WIDTH, D_MODEL), SSM_WIDTH ** -0.5),
        'w_att_out': nrm(21, (DEPTH, ATTN_WIDTH, D_MODEL), ATTN_WIDTH ** -0.5),
        'w_o': nrm(22, (DEPTH, D_MODEL, D_MODEL), DEEPNORM_BETA * D_MODEL ** -0.5),
        'ln1_g': 1.0 + nrm(23, (DEPTH, D_MODEL), 0.02),
        'ln1_b': nrm(24, (DEPTH, D_MODEL), 0.02),
        'w_router': nrm(25, (DEPTH, D_MODEL, E), D_MODEL ** -0.5),
        'b_router': nrm(26, (DEPTH, E), 0.01),
        'w_gate_up': nrm(27, (DEPTH, E, D_MODEL, 2 * F), D_MODEL ** -0.5),
        'b_gate_up': nrm(28, (DEPTH, E, 2 * F), 0.01),
        'w_down': nrm(29, (DEPTH, E, F, D_MODEL), DEEPNORM_BETA * F ** -0.5),
        'b_down': nrm(30, (DEPTH, E, D_MODEL), 0.01),
        'ln2_g': 1.0 + nrm(31, (DEPTH, D_MODEL), 0.02),
        'ln2_b': nrm(32, (DEPTH, D_MODEL), 0.02),
    }


def reference(x, c, ctx, c_ctx, ln_in_g, ln_in_b, w_mod, b_mod, w_in,
              ssm_lam_re, ssm_lam_im, ssm_log_step, ssm_b_re, ssm_b_im, ssm_c_re, ssm_c_im, ssm_d,
              w_glu, b_glu, attn_sink, w_ssm_out, w_att_out, w_o, ln1_g, ln1_b,
              w_router, b_router, w_gate_up, b_gate_up, w_down, b_down, ln2_g, ln2_b):
    bsz, seq_len, _ = x.shape
    rows = seq_len // GRID_W
    row_ids = jnp.repeat(jnp.arange(rows), GRID_W)
    col_ids = jnp.tile(jnp.arange(GRID_W), rows)
    zero_state = jnp.zeros((bsz, SSM_GROUPS, SSM_STATE), jnp.float32)
    h = layer_norm(x, ln_in_g, ln_in_b)
    hc = layer_norm(ctx, ln_in_g, ln_in_b)
    for l in range(DEPTH):
        mod = jax.nn.silu(c) @ w_mod[l] + b_mod[l]
        mod_c = jax.nn.silu(c_ctx) @ w_mod[l] + b_mod[l]
        sh1, sc1, g1, sh2, sc2, g2 = [m[:, None, :] for m in jnp.split(mod, 6, axis=-1)]
        sh1c, sc1c, g1c, sh2c, sc2c, g2c = jnp.split(mod_c, 6, axis=-1)
        disc_f = s5_discretize(ssm_lam_re[l, 0], ssm_lam_im[l, 0], ssm_log_step[l, 0],
                               ssm_b_re[l, 0], ssm_b_im[l, 0])
        disc_b = s5_discretize(ssm_lam_re[l, 1], ssm_lam_im[l, 1], ssm_log_step[l, 1],
                               ssm_b_re[l, 1], ssm_b_im[l, 1])

        uc = modulate(hc, sh1c, sc1c)
        s_in_c, q_c, k_c, v_c, gs_c, ga_c = split_proj(uc @ w_in[l])
        k_c = to_heads(k_c, N_KV_HEADS)
        v_c = to_heads(v_c, N_KV_HEADS)
        ug_c = to_groups(s_in_c)
        cf = s5_scan(ug_c, disc_f, zero_state, zero_state, reverse=False)
        cb = s5_scan(ug_c, disc_b, zero_state, zero_state, reverse=True)

        u = modulate(h, sh1, sc1)
        s_in, q, k, v, gs, ga = split_proj(u @ w_in[l])
        q = rope_2d(to_heads(q, N_Q_HEADS), row_ids, col_ids)
        k = rope_2d(to_heads(k, N_KV_HEADS), row_ids, col_ids)
        o_att = window_attention(q, k, to_heads(v, N_KV_HEADS), k_c, v_c, attn_sink[l])
        ug = to_groups(s_in)
        lf = s5_scan(ug, disc_f, cf[0][:, -1], cf[1][:, -1], reverse=False)
        lb = s5_scan(ug, disc_b, cb[0][:, 0], cb[1][:, 0], reverse=True)
        y_ssm = s5_readout(ug, lf, lb, ssm_c_re[l], ssm_c_im[l], ssm_d[l])
        mix = merge_branches(y_ssm, o_att, gs, ga, w_glu[l], b_glu[l], w_ssm_out[l], w_att_out[l], w_o[l])
        h_new = layer_norm(DEEPNORM_ALPHA * h + g1 * mix, ln1_g[l], ln1_b[l])
        ffn = moe_ffn(modulate(h_new, sh2, sc2), w_router[l], b_router[l],
                      w_gate_up[l], b_gate_up[l], w_down[l], b_down[l])
        h_new = layer_norm(DEEPNORM_ALPHA * h_new + g2 * ffn, ln2_g[l], ln2_b[l])

        if l + 1 < DEPTH:
            o_att_c = context_attention(to_heads(q_c, N_Q_HEADS), k_c, v_c, attn_sink[l])
            y_ssm_c = s5_readout(ug_c, cf, cb, ssm_c_re[l], ssm_c_im[l], ssm_d[l])
            mix_c = merge_branches(y_ssm_c, o_att_c, gs_c, ga_c, w_glu[l], b_glu[l],
                                   w_ssm_out[l], w_att_out[l], w_o[l])
            hc = layer_norm(DEEPNORM_ALPHA * hc + g1c * mix_c, ln1_g[l], ln1_b[l])
            ffn_c = moe_ffn(modulate(hc, sh2c, sc2c), w_router[l], b_router[l],
                            w_gate_up[l], b_gate_up[l], w_down[l], b_down[l])
            hc = layer_norm(DEEPNORM_ALPHA * hc + g2c * ffn_c, ln2_g[l], ln2_b[l])
        h = h_new
    return h
```

```cpp
#include <hip/hip_runtime.h>
#include <hip/hip_cooperative_groups.h>
#include <cstdint>
#include <cstdio>
namespace cg = cooperative_groups;

#ifndef MK_MULTI
#define MK_MULTI 0
#endif

#define LAS __attribute__((address_space(3)))
#define GAS __attribute__((address_space(1)))
typedef unsigned short bf16_t;
typedef short bf16x8 __attribute__((ext_vector_type(8)));
typedef float f32x4 __attribute__((ext_vector_type(4)));
typedef float f32x2 __attribute__((ext_vector_type(2)));
typedef float f32x16 __attribute__((ext_vector_type(16)));
typedef unsigned u32x4 __attribute__((ext_vector_type(4)));
typedef unsigned u32x2 __attribute__((ext_vector_type(2)));
typedef __bf16 bf16x2_t __attribute__((ext_vector_type(2)));

constexpr int D = 1024, NB = 4, SEQ = 4096, CTX = 256;
constexpr int MTOK = NB * SEQ;
constexpr int MCTX = NB * CTX;
constexpr int MALL = MTOK + MCTX;
constexpr int INC = 3328;
constexpr int NE = 32, FE = 1024;
constexpr int SG = 32, SP = 64, SH = 16, CH = 32;
constexpr int SROWS = 768;
constexpr int SK = 768;
constexpr float LN_EPS = 1e-5f;
constexpr float DN_ALPHA = 1.189207115002721f;
constexpr float LOG2E = 1.4426950408889634f;
constexpr int LCAP = 16384;
constexpr int HCAP = 65536 + NE * 256;

constexpr size_t MiB = 1u << 20;
constexpr size_t WS_CTL = 0, CTL_BYTES = 1 * MiB;
constexpr size_t WS_MOD = 1 * MiB;
constexpr size_t WS_ROPE = 1 * MiB + 128 * 1024;
constexpr size_t WS_ST0 = 1 * MiB + 256 * 1024;
constexpr size_t WS_ST1 = 1 * MiB + 512 * 1024;
constexpr size_t WS_TOKE = 2 * MiB;
constexpr size_t WS_TOKP = 2 * MiB + 256 * 1024;
constexpr size_t WS_TOKG = 2 * MiB + 512 * 1024;
constexpr size_t WS_LIST = 3 * MiB;
constexpr size_t WS_LGATE = 5 * MiB;
constexpr size_t WS_WINT = 8 * MiB;
constexpr size_t WS_WGLUT = 15 * MiB;
constexpr size_t WS_WSOT = 16 * MiB;
constexpr size_t WS_WAOT = 17 * MiB;
constexpr size_t WS_WOT = 18 * MiB;
constexpr size_t WS_BTL = 20 * MiB;
constexpr size_t WS_BTY = 28 * MiB;
constexpr size_t WS_WGUT = 52 * MiB;
constexpr size_t WS_WDT = 180 * MiB;
constexpr size_t WS_R1 = 244 * MiB;
constexpr size_t WS_XF = 308 * MiB;
constexpr size_t WS_U = 340 * MiB;
constexpr size_t WS_AP = 374 * MiB;
constexpr size_t WS_Q = 410 * MiB;
constexpr size_t WS_KB = 426 * MiB;
constexpr size_t WS_VB = 431 * MiB;
constexpr size_t WS_SGB = 436 * MiB;
constexpr size_t WS_SAB = 468 * MiB;
constexpr size_t WS_LBUF = 500 * MiB;
constexpr size_t WS_Z = 524 * MiB;
constexpr size_t WS_Z2 = 540 * MiB;
constexpr size_t WS_OATT = 556 * MiB;
constexpr size_t WS_TMP = 572 * MiB;
constexpr size_t WS_MB = 636 * MiB;
constexpr size_t WS_H = 340 * MiB;
constexpr size_t WS_YR = 484 * MiB;
constexpr size_t WS_END = 668 * MiB;
static_assert(WS_H + (size_t)HCAP * 1024 * 2 <= WS_YR && WS_YR + (size_t)HCAP * 1024 * 2 <= WS_MB, "MoE overlay");
constexpr int CW_GCNT = 64;
constexpr int CW_BAR = 4096;

constexpr int RING_BYTES = 131072;
constexpr int MISC_OFF = RING_BYTES;
constexpr int LDS_BYTES = 147456;
constexpr int NWAVES = 8, NTHR = 512;

__device__ __forceinline__ unsigned cvtpk(float lo, float hi) { f32x2 v = {lo, hi}; bf16x2_t b = __builtin_convertvector(v, bf16x2_t); return __builtin_bit_cast(unsigned, b); }
__device__ __forceinline__ float bf2f(unsigned short h) { return __uint_as_float((unsigned)h << 16); }
__device__ __forceinline__ float bflo(unsigned w) { return __uint_as_float(w << 16); }
__device__ __forceinline__ float bfhi(unsigned w) { return __uint_as_float(w & 0xffff0000u); }
__device__ __forceinline__ float sigmoidf_(float v) { return __builtin_amdgcn_rcpf(1.f + __expf(-v)); }
__device__ __forceinline__ float wave_sum(float v) {
#pragma unroll
    for (int o = 1; o < 64; o <<= 1) v += __shfl_xor(v, o);
    return v;
}
#define LDS_WAIT() asm volatile("s_waitcnt lgkmcnt(0)" ::: "memory")
#define VM_WAIT() asm volatile("s_waitcnt vmcnt(0)" ::: "memory")

namespace pg8 {
constexpr int BM = 256, BK = 64, HALF = 128, HTB = HALF * BK * 2, STAGE_BYTES = 8 * HTB;
__device__ __forceinline__ int lds_byte(int r, int c) { const int st = (r >> 4) * 2 + (c >> 5), rr = r & 15, cc = c & 31, ob = rr * 64 + cc * 2; return st * 1024 + (ob ^ (((ob >> 9) & 1) << 5)); }
__device__ __forceinline__ void stage_rc(int b, int& R, int& C) { const int st = b / 1024, sb = b % 1024, swz = sb ^ (((sb >> 9) & 1) << 5); R = (st >> 1) * 16 + swz / 64; C = (st & 1) * 32 + (swz % 64) / 2; }
__device__ __forceinline__ int perm32(int rho) { const int n = rho >> 4, i = rho & 15; return 8 * (i >> 2) + 4 * n + (i & 3); }

struct Unit { const char* a; const char* b; int pm, pn, aux; };

template <class Epi, class Sched, bool ALIGN_EPI>
__device__ __forceinline__ void gemm_phase(LAS unsigned char* lds, const int K, const unsigned lda2, const Sched& S, const Epi& E) {
    const int tid = threadIdx.x, wid = __builtin_amdgcn_readfirstlane(tid >> 6), lane = tid & 63, wr = wid >> 2, wc = wid & 3, fr = lane & 15, fq = lane >> 4;
    const int nt = K / BK;
    int Rl[2], Cl[2]; unsigned voffB[2];
#pragma unroll
    for (int i = 0; i < 2; ++i) { stage_rc(tid * 16 + i * 8192, Rl[i], Cl[i]); const int Rb = Epi::PERM ? ((Rl[i] & ~31) + perm32(Rl[i] & 31)) : Rl[i]; voffB[i] = (unsigned)(Rb * K + Cl[i]) * 2u; }
    const size_t kstep = (size_t)(BK * 2);
    const size_t hstepB = (size_t)HALF * K * 2;
    const unsigned ldsw = (unsigned)wid * 1024u;
    const int aoff = lds_byte(wr * 64 + fr, fq * 8), boff = lds_byte(wc * 32 + fr, fq * 8);
#define PG8_SA(b, h) (((b) * 2 + (h)) * HTB)
#define PG8_SB(b, h) ((4 + (b) * 2 + (h)) * HTB)
#define PG8_STAGE(bufoff, gbase, v0, v1) do { \
        __builtin_amdgcn_global_load_lds((const unsigned*)((const char*)(gbase) + (v0)), (LAS unsigned*)(lds + (bufoff) + ldsw), 16, 0, 0); \
        __builtin_amdgcn_global_load_lds((const unsigned*)((const char*)(gbase) + (v1)), (LAS unsigned*)(lds + (bufoff) + ldsw + 8192), 16, 0, 0); } while (0)
#define PG8_STAGEB(bufoff, gbase) PG8_STAGE(bufoff, gbase, voffB[0], voffB[1])
#define PG8_LDA(dst, b, h) do { _Pragma("unroll") for (int m = 0; m < 4; ++m) _Pragma("unroll") for (int k = 0; k < 2; ++k) dst[m][k] = *(const LAS bf16x8*)(lds + PG8_SA(b, h) + aoff + m * 2048 + k * 1024); } while (0)
#define PG8_LDB(dst, b, h) do { _Pragma("unroll") for (int n = 0; n < 2; ++n) _Pragma("unroll") for (int k = 0; k < 2; ++k) dst[n][k] = *(const LAS bf16x8*)(lds + PG8_SB(b, h) + boff + n * 2048 + k * 1024); } while (0)
#define PG8_MMA(ai, bj, At, Bt) do { __builtin_amdgcn_s_setprio(1); _Pragma("unroll") for (int m = 0; m < 4; ++m) _Pragma("unroll") for (int n = 0; n < 2; ++n) _Pragma("unroll") for (int k = 0; k < 2; ++k) \
        acc[ai][bj][m][n] = __builtin_amdgcn_mfma_f32_16x16x32_bf16(Bt[n][k], At[m][k], acc[ai][bj][m][n], 0, 0, 0); __builtin_amdgcn_s_setprio(0); } while (0)
#define PG8_WAIT_V(n) asm volatile("s_waitcnt vmcnt(" #n ")" ::: "memory")
#define PG8_WAIT_L(n) asm volatile("s_waitcnt lgkmcnt(" #n ")" ::: "memory")
#define PG8_BAR __builtin_amdgcn_s_barrier()
#define PG8_SCHED __builtin_amdgcn_sched_barrier(0)
#define PG8_SETA(v, u) do { _Pragma("unroll") for (int h_ = 0; h_ < 2; ++h_) _Pragma("unroll") for (int i_ = 0; i_ < 2; ++i_) { \
        const unsigned row_ = Sched::GATHER ? S.arow(u, h_ * HALF + Rl[i_]) : (unsigned)(h_ * HALF + Rl[i_]); v[h_][i_] = row_ * lda2 + (unsigned)Cl[i_] * 2u; } } while (0)
    Unit cur, nxt; int ui = 0;
    if (!S.next(0, cur)) return;
    f32x4 acc[2][2][4][2];
#pragma unroll
    for (int a = 0; a < 2; ++a)
#pragma unroll
        for (int b = 0; b < 2; ++b)
#pragma unroll
            for (int m = 0; m < 4; ++m)
#pragma unroll
                for (int n = 0; n < 2; ++n) acc[a][b][m][n] = (f32x4){0.f, 0.f, 0.f, 0.f};
    bf16x8 At[4][2], B0[2][2], B1[2][2];
    unsigned vc[2][2], vn[2][2];
    PG8_SETA(vc, cur);
    const char* cA = cur.a; const char* cB = cur.b;
    PG8_STAGEB(PG8_SB(0, 0), cB); PG8_STAGEB(PG8_SB(0, 1), cB + hstepB); PG8_STAGE(PG8_SA(0, 0), cA, vc[0][0], vc[0][1]); PG8_STAGE(PG8_SA(0, 1), cA, vc[1][0], vc[1][1]);
    if (wr == 1) PG8_BAR;
    PG8_WAIT_V(2); PG8_BAR;
    PG8_STAGEB(PG8_SB(1, 0), cB + kstep); PG8_STAGE(PG8_SA(1, 0), cA + kstep, vc[0][0], vc[0][1]); PG8_STAGEB(PG8_SB(1, 1), cB + hstepB + kstep);
    PG8_WAIT_V(6); PG8_BAR;
    for (;;) {
        const bool has_next = S.next(ui + 1, nxt);
        const char* nA = has_next ? nxt.a : cA; const char* nB = has_next ? nxt.b : cB;
        if (Sched::GATHER) { if (has_next) { PG8_SETA(vn, nxt); } else {
#pragma unroll
            for (int h = 0; h < 2; ++h) { vn[h][0] = vc[h][0]; vn[h][1] = vc[h][1]; } } }
        for (int t = 0; t < nt; t += 2) {
            const bool last = (t == nt - 2);
            const char* a1 = cA + (size_t)(t + 1) * kstep;
            const char* a2 = last ? nA : cA + (size_t)(t + 2) * kstep; const char* b2 = last ? nB : cB + (size_t)(t + 2) * kstep;
            const char* a3 = a2 + kstep; const char* b3 = b2 + kstep;
            unsigned v2[2][2];
#pragma unroll
            for (int h = 0; h < 2; ++h) { v2[h][0] = (Sched::GATHER && last) ? vn[h][0] : vc[h][0]; v2[h][1] = (Sched::GATHER && last) ? vn[h][1] : vc[h][1]; }
            PG8_LDB(B0, 0, 0); PG8_LDB(B1, 0, 1); PG8_SCHED; PG8_LDA(At, 0, 0); PG8_STAGE(PG8_SA(1, 1), a1, vc[1][0], vc[1][1]);
            PG8_WAIT_V(8); PG8_WAIT_L(0); PG8_BAR; PG8_MMA(0, 0, At, B0); PG8_MMA(0, 1, At, B1); PG8_BAR; PG8_SCHED;
            PG8_LDA(At, 0, 1); PG8_STAGEB(PG8_SB(0, 0), b2); PG8_STAGEB(PG8_SB(0, 1), b2 + hstepB); PG8_STAGE(PG8_SA(0, 0), a2, v2[0][0], v2[0][1]);
            PG8_WAIT_V(8); PG8_WAIT_L(0); PG8_BAR; PG8_MMA(1, 0, At, B0); PG8_MMA(1, 1, At, B1); PG8_BAR; PG8_SCHED;
            PG8_LDB(B0, 1, 0); PG8_LDB(B1, 1, 1); PG8_SCHED; PG8_LDA(At, 1, 0); PG8_STAGE(PG8_SA(0, 1), a2, v2[1][0], v2[1][1]);
            PG8_WAIT_V(8); PG8_WAIT_L(0); PG8_BAR; PG8_MMA(0, 0, At, B0); PG8_MMA(0, 1, At, B1); PG8_BAR; PG8_SCHED;
            PG8_LDA(At, 1, 1); PG8_STAGEB(PG8_SB(1, 0), b3); PG8_STAGEB(PG8_SB(1, 1), b3 + hstepB); PG8_STAGE(PG8_SA(1, 0), a3, v2[0][0], v2[0][1]);
            PG8_WAIT_V(8); PG8_WAIT_L(0); PG8_BAR; PG8_MMA(1, 0, At, B0); PG8_MMA(1, 1, At, B1); PG8_BAR; PG8_SCHED;
        }
        if constexpr (ALIGN_EPI) { if (wr == 0) PG8_BAR; }
        E(acc, cur, wr, wc, fr, fq);
        if (!has_next) break;
#pragma unroll
        for (int a = 0; a < 2; ++a)
#pragma unroll
            for (int b = 0; b < 2; ++b)
#pragma unroll
                for (int m = 0; m < 4; ++m)
#pragma unroll
                    for (int n = 0; n < 2; ++n) acc[a][b][m][n] = (f32x4){0.f, 0.f, 0.f, 0.f};
        cur = nxt; cA = nA; cB = nB; ++ui;
        if (Sched::GATHER) {
#pragma unroll
            for (int h = 0; h < 2; ++h) { vc[h][0] = vn[h][0]; vc[h][1] = vn[h][1]; } }
        if constexpr (ALIGN_EPI) { if (wr == 1) PG8_BAR; }
    }
    PG8_WAIT_V(0);
    if constexpr (!ALIGN_EPI) { if (wr == 0) PG8_BAR; }
    PG8_BAR;
#undef PG8_SA
#undef PG8_SB
#undef PG8_STAGE
#undef PG8_STAGEB
#undef PG8_LDA
#undef PG8_LDB
#undef PG8_MMA
#undef PG8_WAIT_V
#undef PG8_WAIT_L
#undef PG8_BAR
#undef PG8_SCHED
#undef PG8_SETA
}
}

using pg8::Unit;
__device__ __forceinline__ float gelu_tanh(float x) {
    const float t = 1.5957691216057308f * (x + 0.044715f * x * x * x);
    return x * __builtin_amdgcn_rcpf(1.f + __expf(-t));
}
__device__ __forceinline__ u32x4 pack8(const f32x4 a, const f32x4 b) { u32x4 w; w.x = cvtpk(a[0], a[1]); w.y = cvtpk(a[2], a[3]); w.z = cvtpk(b[0], b[1]); w.w = cvtpk(b[2], b[3]); return w; }

struct EpiG1 {
    static constexpr bool PERM = true;
    bf16_t *AP, *Q, *KB, *VB, *SGB, *SAB; const float* rope;
    __device__ __forceinline__ void operator()(const f32x4 (&acc)[2][2][4][2], const Unit& u, int wr, int wc, int fr, int fq) const {
        const int pn = u.pn;
#pragma unroll
        for (int ai = 0; ai < 2; ++ai)
#pragma unroll
            for (int m = 0; m < 4; ++m) {
                const int row = u.pm * 256 + ai * 128 + wr * 64 + m * 16 + fr;
#pragma unroll
                for (int bj = 0; bj < 2; ++bj) {
                    const int col = pn * 256 + bj * 128 + wc * 32 + 8 * fq;
                    f32x4 v0 = acc[ai][bj][m][0], v1 = acc[ai][bj][m][1];
                    if (pn < 2) {
                        const int g = col >> 4, h0 = col & 15;
                        const int crow = row < MTOK ? (row >> 5) : (512 + ((row - MTOK) >> 5));
                        *(u32x4*)(AP + ((size_t)(g * SROWS + crow) * SK + (row & 31) * 16 + h0)) = pack8(v0, v1);
                    } else if (pn < 4 || (pn == 4 && bj == 0)) {
                        const bool isq = pn < 4;
                        const int cc = isq ? (col - 512) : (col - 1024);
                        if (row < MTOK) {
                            const int hc = cc & 63, i0 = hc >> 1;
                            const int t = row & (SEQ - 1);
                            const int pos = (i0 < 16) ? (t >> 6) : (t & 63);
                            const float* rp = rope + (pos * 16 + (i0 & 15)) * 2;
                            const f32x4 cs0 = *(const f32x4*)rp, cs1 = *(const f32x4*)(rp + 4);
                            f32x4 o0, o1;
                            o0[0] = v0[0] * cs0[0] - v0[1] * cs0[1]; o0[1] = v0[1] * cs0[0] + v0[0] * cs0[1];
                            o0[2] = v0[2] * cs0[2] - v0[3] * cs0[3]; o0[3] = v0[3] * cs0[2] + v0[2] * cs0[3];
                            o1[0] = v1[0] * cs1[0] - v1[1] * cs1[1]; o1[1] = v1[1] * cs1[0] + v1[0] * cs1[1];
                            o1[2] = v1[2] * cs1[2] - v1[3] * cs1[3]; o1[3] = v1[3] * cs1[2] + v1[2] * cs1[3];
                            v0 = o0; v1 = o1;
                        }
                        if (isq) { const float sc = 0.125f * LOG2E; v0 = v0 * sc; v1 = v1 * sc; *(u32x4*)(Q + ((size_t)row * 512 + cc)) = pack8(v0, v1); }
                        else *(u32x4*)(KB + ((size_t)row * 128 + cc)) = pack8(v0, v1);
                    } else if (pn == 4) {
                        *(u32x4*)(VB + ((size_t)row * 128 + (col - 1152))) = pack8(v0, v1);
                    } else {
#pragma unroll
                        for (int e = 0; e < 4; ++e) { v0[e] = sigmoidf_(v0[e]); v1[e] = sigmoidf_(v1[e]); }
                        if (pn < 9) *(u32x4*)(SGB + ((size_t)row * 1024 + (col - 1280))) = pack8(v0, v1);
                        else *(u32x4*)(SAB + ((size_t)row * 1024 + (col - 2304))) = pack8(v0, v1);
                    }
                }
            }
    }
};
struct EpiS5L {
    static constexpr bool PERM = false;
    float* L;
    __device__ __forceinline__ void operator()(const f32x4 (&acc)[2][2][4][2], const Unit& u, int wr, int wc, int fr, int fq) const {
#pragma unroll
        for (int ai = 0; ai < 2; ++ai)
#pragma unroll
            for (int m = 0; m < 4; ++m) {
                const int row = u.pm * 256 + ai * 128 + wr * 64 + m * 16 + fr;
                float* rp = L + ((size_t)(u.aux * SROWS + row) * 256 + wc * 32 + 4 * fq);
#pragma unroll
                for (int bj = 0; bj < 2; ++bj)
#pragma unroll
                    for (int n = 0; n < 2; ++n) *(f32x4*)(rp + bj * 128 + n * 16) = acc[ai][bj][m][n];
            }
    }
};
struct EpiS5Y {
    static constexpr bool PERM = true;
    bf16_t* Z;
    __device__ __forceinline__ void operator()(const f32x4 (&acc)[2][2][4][2], const Unit& u, int wr, int wc, int fr, int fq) const {
#pragma unroll
        for (int ai = 0; ai < 2; ++ai)
#pragma unroll
            for (int m = 0; m < 4; ++m) {
                const int crow = u.pm * 256 + ai * 128 + wr * 64 + m * 16 + fr;
#pragma unroll
                for (int bj = 0; bj < 2; ++bj) {
                    const int col = u.pn * 256 + bj * 128 + wc * 32 + 8 * fq;
                    const int tok = crow * 32 + (col >> 4);
                    f32x4 v0 = acc[ai][bj][m][0], v1 = acc[ai][bj][m][1];
#pragma unroll
                    for (int e = 0; e < 4; ++e) { v0[e] = gelu_tanh(v0[e]); v1[e] = gelu_tanh(v1[e]); }
                    *(u32x4*)(Z + ((size_t)tok * 512 + u.aux * 16 + (col & 15))) = pack8(v0, v1);
                }
            }
    }
};
struct EpiGLU {
    static constexpr bool PERM = true;
    const bf16_t* Z; bf16_t* Z2; const float* bias;
    __device__ __forceinline__ void operator()(const f32x4 (&acc)[2][2][4][2], const Unit& u, int wr, int wc, int fr, int fq) const {
#pragma unroll
        for (int bj = 0; bj < 2; ++bj) {
            const int col = u.pn * 256 + bj * 128 + wc * 32 + 8 * fq;
            const f32x4 b0 = *(const f32x4*)(bias + col), b1 = *(const f32x4*)(bias + col + 4);
#pragma unroll
            for (int ai = 0; ai < 2; ++ai)
#pragma unroll
                for (int m = 0; m < 4; ++m) {
                    const int row = u.pm * 256 + ai * 128 + wr * 64 + m * 16 + fr;
                    const u32x4 zz = *(const u32x4*)(Z + ((size_t)row * 512 + col));
                    f32x4 v0 = acc[ai][bj][m][0] + b0, v1 = acc[ai][bj][m][1] + b1;
                    v0[0] = bflo(zz.x) * sigmoidf_(v0[0]); v0[1] = bfhi(zz.x) * sigmoidf_(v0[1]); v0[2] = bflo(zz.y) * sigmoidf_(v0[2]); v0[3] = bfhi(zz.y) * sigmoidf_(v0[3]);
                    v1[0] = bflo(zz.z) * sigmoidf_(v1[0]); v1[1] = bfhi(zz.z) * sigmoidf_(v1[1]); v1[2] = bflo(zz.w) * sigmoidf_(v1[2]); v1[3] = bfhi(zz.w) * sigmoidf_(v1[3]);
                    *(u32x4*)(Z2 + ((size_t)row * 512 + col)) = pack8(v0, v1);
                }
        }
    }
};
struct EpiMerge {
    static constexpr bool PERM = false;
    const bf16_t *SGB, *SAB; float* TMP; bf16_t* MB;
    __device__ __forceinline__ void operator()(const f32x4 (&acc)[2][2][4][2], const Unit& u, int wr, int wc, int fr, int fq) const {
        const bf16_t* gsrc = u.aux ? SAB : SGB;
#pragma unroll
        for (int ai = 0; ai < 2; ++ai)
#pragma unroll
            for (int m = 0; m < 4; ++m) {
                const int row = u.pm * 256 + ai * 128 + wr * 64 + m * 16 + fr;
#pragma unroll
                for (int bj = 0; bj < 2; ++bj)
#pragma unroll
                    for (int n = 0; n < 2; ++n) {
                        const size_t off = (size_t)row * 1024 + u.pn * 256 + bj * 128 + wc * 32 + n * 16 + 4 * fq;
                        const u32x2 gg = *(const u32x2*)(gsrc + off);
                        f32x4 v = acc[ai][bj][m][n];
                        v[0] *= bflo(gg.x); v[1] *= bfhi(gg.x); v[2] *= bflo(gg.y); v[3] *= bfhi(gg.y);
                        if (u.aux == 0) *(f32x4*)(TMP + off) = v;
                        else { v = v + *(const f32x4*)(TMP + off); u32x2 w; w.x = cvtpk(v[0], v[1]); w.y = cvtpk(v[2], v[3]); *(u32x2*)(MB + off) = w; }
                    }
            }
    }
};
struct EpiWO {
    static constexpr bool PERM = false;
    const float *x, *st0, *lg, *lb, *mod; float* R1;
    __device__ __forceinline__ void operator()(const f32x4 (&acc)[2][2][4][2], const Unit& u, int wr, int wc, int fr, int fq) const {
        const int b = u.pm >> 4;
        const float* g1 = mod + b * 6144 + 2 * 1024;
#pragma unroll
        for (int bj = 0; bj < 2; ++bj)
#pragma unroll
            for (int n = 0; n < 2; ++n) {
                const int col = u.pn * 256 + bj * 128 + wc * 32 + n * 16 + 4 * fq;
                const f32x4 gv = *(const f32x4*)(g1 + col), lgv = *(const f32x4*)(lg + col), lbv = *(const f32x4*)(lb + col);
#pragma unroll
                for (int ai = 0; ai < 2; ++ai)
#pragma unroll
                    for (int m = 0; m < 4; ++m) {
                        const int row = u.pm * 256 + ai * 128 + wr * 64 + m * 16 + fr;
                        const f32x2 st = *(const f32x2*)(st0 + row * 2);
                        const f32x4 xv = *(const f32x4*)(x + (size_t)row * 1024 + col);
                        const f32x4 h = (xv - st.x) * st.y * lgv + lbv;
                        *(f32x4*)(R1 + (size_t)row * 1024 + col) = h * DN_ALPHA + gv * acc[ai][bj][m][n];
                    }
            }
    }
};
struct MoeTab { volatile LAS int* t; };
struct EpiMoe1 {
    static constexpr bool PERM = true;
    bf16_t* H; const float* bgu;
    __device__ __forceinline__ void operator()(const f32x4 (&acc)[2][2][4][2], const Unit& u, int wr, int wc, int fr, int fq) const {
        const int f0 = u.pn * 128 + wc * 32 + 8 * fq;
        const float* bp = bgu + (size_t)u.aux * 2048 + f0;
        const f32x4 bg0 = *(const f32x4*)bp, bg1 = *(const f32x4*)(bp + 4), bl0 = *(const f32x4*)(bp + 1024), bl1 = *(const f32x4*)(bp + 1028);
#pragma unroll
        for (int ai = 0; ai < 2; ++ai)
#pragma unroll
            for (int m = 0; m < 4; ++m) {
                const int row = u.pm * 256 + ai * 128 + wr * 64 + m * 16 + fr;
                f32x4 g0 = acc[ai][0][m][0] + bg0, g1 = acc[ai][0][m][1] + bg1, l0 = acc[ai][1][m][0] + bl0, l1 = acc[ai][1][m][1] + bl1;
#pragma unroll
                for (int e = 0; e < 4; ++e) {
                    float ga = fminf(g0[e], 7.f), la = fminf(fmaxf(l0[e], -7.f), 7.f); g0[e] = ga * sigmoidf_(1.702f * ga) * (la + 1.f);
                    ga = fminf(g1[e], 7.f); la = fminf(fmaxf(l1[e], -7.f), 7.f); g1[e] = ga * sigmoidf_(1.702f * ga) * (la + 1.f);
                }
                *(u32x4*)(H + ((size_t)row * 1024 + f0)) = pack8(g0, g1);
            }
    }
};
struct EpiMoe2 {
    static constexpr bool PERM = true;
    bf16_t* YR; const float* bd; const float* lgate; MoeTab tab;
    __device__ __forceinline__ void operator()(const f32x4 (&acc)[2][2][4][2], const Unit& u, int wr, int wc, int fr, int fq) const {
        const int e = u.aux, rt = u.pm - tab.t[e], cnt = tab.t[64 + e];
#pragma unroll
        for (int bj = 0; bj < 2; ++bj) {
            const int col = u.pn * 256 + bj * 128 + wc * 32 + 8 * fq;
            const f32x4 b0 = *(const f32x4*)(bd + (size_t)e * 1024 + col), b1 = *(const f32x4*)(bd + (size_t)e * 1024 + col + 4);
#pragma unroll
            for (int ai = 0; ai < 2; ++ai)
#pragma unroll
                for (int m = 0; m < 4; ++m) {
                    const int lr = ai * 128 + wr * 64 + m * 16 + fr, idx = rt * 256 + lr;
                    const float gt = idx < cnt ? lgate[(size_t)e * LCAP + idx] : 0.f;
                    const f32x4 v0 = (acc[ai][bj][m][0] + b0) * gt, v1 = (acc[ai][bj][m][1] + b1) * gt;
                    *(u32x4*)(YR + ((size_t)(u.pm * 256 + lr) * 1024 + col)) = pack8(v0, v1);
                }
        }
    }
};

struct SchedG1 {
    static constexpr bool GATHER = false;
    const char *A, *Bt; int G, vcu;
    __device__ __forceinline__ bool next(int i, Unit& u) const {
        const int L = i * G + vcu; if (L >= 844) return false;
        int pm, pn;
        if (L < 832) { const int grp = L / 104, w = L % 104; pm = grp * 8 + (w & 7); pn = w >> 3; }
        else { const int j = L - 832; pm = 64 + (j & 3); const int c = j >> 2; pn = c == 2 ? 4 : c; }
        u.pm = pm; u.pn = pn; u.aux = 0; u.a = A + (size_t)pm * 256 * 2048; u.b = Bt + (size_t)pn * 256 * 2048; return true;
    }
    __device__ __forceinline__ unsigned arow(const Unit&, int R) const { return (unsigned)R; }
};
struct SchedS5L {
    static constexpr bool GATHER = false;
    const char *AP, *BTL; int G, vcu;
    __device__ __forceinline__ bool next(int i, Unit& u) const {
        const int L = i * G + vcu; if (L >= 96) return false;
        const int g = L / 3, pm = L % 3;
        u.pm = pm; u.pn = 0; u.aux = g; u.a = AP + ((size_t)(g * SROWS + pm * 256) * SK) * 2; u.b = BTL + (size_t)g * 256 * 512 * 2; return true;
    }
    __device__ __forceinline__ unsigned arow(const Unit&, int R) const { return (unsigned)R; }
};
struct SchedS5Y {
    static constexpr bool GATHER = false;
    const char *AP, *BTY; int G, vcu;
    __device__ __forceinline__ bool next(int i, Unit& u) const {
        const int L = i * G + vcu; if (L >= 128) return false;
        const int g = L >> 2, pm = (L >> 1) & 1, pn = L & 1;
        u.pm = pm; u.pn = pn; u.aux = g; u.a = AP + ((size_t)(g * SROWS + pm * 256) * SK) * 2; u.b = BTY + ((size_t)(g * 512 + pn * 256) * SK) * 2; return true;
    }
    __device__ __forceinline__ unsigned arow(const Unit&, int R) const { return (unsigned)R; }
};
struct SchedPlain {
    static constexpr bool GATHER = false;
    const char *A, *Bt; int nM, nN, K, G, vcu;
    __device__ __forceinline__ bool next(int i, Unit& u) const {
        const int L = i * G + vcu; if (L >= nM * nN) return false;
        const int nig = 8 * nN, grp = L / nig, w = L % nig;
        u.pm = grp * 8 + (w & 7); u.pn = w >> 3; u.aux = 0;
        u.a = A + (size_t)u.pm * 256 * K * 2; u.b = Bt + (size_t)u.pn * 256 * K * 2; return true;
    }
    __device__ __forceinline__ unsigned arow(const Unit&, int R) const { return (unsigned)R; }
};
struct SchedMerge {
    static constexpr bool GATHER = false;
    const char *Z2, *OA, *WSO, *WAO; int G, vcu;
    __device__ __forceinline__ bool next(int i, Unit& u) const {
        const int tile = (i >> 1) * G + vcu; if (tile >= 256) return false;
        const int part = i & 1, grp = tile >> 5, w = tile & 31;
        u.pm = grp * 8 + (w & 7); u.pn = w >> 3; u.aux = part;
        u.a = (part ? OA : Z2) + (size_t)u.pm * 256 * 512 * 2; u.b = (part ? WAO : WSO) + (size_t)u.pn * 256 * 512 * 2; return true;
    }
    __device__ __forceinline__ unsigned arow(const Unit&, int R) const { return (unsigned)R; }
};
template <int NPN, bool GATH>
struct SchedMoe {
    static constexpr bool GATHER = GATH;
    const char *A, *Bt; const int* list; MoeTab tab; int G, vcu;
    __device__ __forceinline__ bool next(int i, Unit& u) const {
        const int L = i * G + vcu; const int total = tab.t[32] * NPN; if (L >= total) return false;
        int e = 0;
        while (e < 31 && tab.t[e + 1] * NPN <= L) ++e;
        const int tb = tab.t[e], nt = tab.t[e + 1] - tb, w = L - tb * NPN;
        const int pn = w / nt, rt = w % nt;
        u.pm = tb + rt; u.pn = pn; u.aux = e;
        if (GATH) { u.a = A; u.b = Bt + ((size_t)e * 2048 + pn * 256) * 2048; }
        else { u.a = A + (size_t)u.pm * 256 * 2048; u.b = Bt + ((size_t)e * 1024 + pn * 256) * 2048; }
        return true;
    }
    __device__ __forceinline__ unsigned arow(const Unit& u, int R) const {
        const int e = u.aux, idx = (u.pm - tab.t[e]) * 256 + R;
        return idx < tab.t[64 + e] ? (unsigned)list[(size_t)e * LCAP + idx] : 0u;
    }
};

struct Args { const void* in[33]; float* out; unsigned char* ws; int ph_lo, ph_hi; };
struct Frame {
    LAS unsigned char* lds; volatile LAS int* MISC;
    int tid, lane, wave, vcu, G;
    unsigned char* ws; const Args* a;
};
#define IN_F(k) ((const float*)args.in[k])
enum { I_X = 0, I_C, I_CTX, I_CCTX, I_LNG, I_LNB, I_WMOD, I_BMOD, I_WIN, I_LRE, I_LIM, I_LSTEP, I_BRE, I_BIM, I_CRE, I_CIM, I_SD, I_WGLU, I_BGLU, I_SINK, I_WSO, I_WAO, I_WO,
       I_LN1G, I_LN1B, I_WR, I_BR, I_WGU, I_BGU, I_WD, I_BD, I_LN2G, I_LN2B };

template <int MAP> __device__ __forceinline__ int dest_row(int n) {
    if (MAP == 1) { return (n >= 512 && n < 1152) ? ((n & ~63) + 2 * (n & 31) + ((n >> 5) & 1)) : n; }
    if (MAP == 2) { const int f = n & 1023, lin = n >> 10; return (f >> 7) * 256 + lin * 128 + (f & 127); }
    return n;
}
template <int MAP> __device__ __forceinline__ void transpose_item(const float* W, int K, int N, bf16_t* WT, LAS float* scr, int item, int lane) {
    const int nblk = N / 32, kb = item / nblk, nb = item % nblk, k0 = 64 * kb, n0 = 32 * nb;
#pragma unroll 8
    for (int i = 0; i < 32; ++i) { const int kk = 2 * i + (lane >> 5); scr[kk * 33 + (lane & 31)] = W[(size_t)(k0 + kk) * N + n0 + (lane & 31)]; }
    LDS_WAIT(); asm volatile("" ::: "memory");
    const int c = lane & 7;
#pragma unroll
    for (int j = 0; j < 4; ++j) { const int n = (lane >> 3) + 8 * j; const LAS float* s = scr + (8 * c) * 33 + n;
        u32x4 o; o.x = cvtpk(s[0 * 33], s[1 * 33]); o.y = cvtpk(s[2 * 33], s[3 * 33]); o.z = cvtpk(s[4 * 33], s[5 * 33]); o.w = cvtpk(s[6 * 33], s[7 * 33]);
        *(u32x4*)(WT + (size_t)dest_row<MAP>(n0 + n) * K + k0 + 8 * c) = o; }
    LDS_WAIT(); asm volatile("" ::: "memory");
}
struct Cx { float re, im; };
__device__ __forceinline__ Cx cmul(Cx a, Cx b) { return Cx{a.re * b.re - a.im * b.im, a.re * b.im + a.im * b.re}; }
__device__ __forceinline__ Cx apow(float lr, float li, float dt, float n) {
    const float mag = expf(lr * dt * n); const float ang = li * dt * n;
    const float k = rintf(ang * 0.15915494309189535f); float r = fmaf(-k, 6.2831854820251465f, ang); r = fmaf(-k, -1.7484555e-7f, r);
    float s, c; sincosf(r, &s, &c); return Cx{mag * c, mag * s};
}
__device__ __forceinline__ Cx s5coef(float lr, float li, float dt) {
    const Cx a = apow(lr, li, dt, 1.f); const float den = lr * lr + li * li; const float ar1 = a.re - 1.f;
    return Cx{(ar1 * lr + a.im * li) / den, (a.im * lr - ar1 * li) / den};
}

__device__ __forceinline__ void p0_prep(const Args& args, Frame& F) {
    unsigned char* ws = F.ws;
    {
        LAS float* sc = (LAS float*)F.lds; LAS float* red = sc + 5 * 1024;
        const float* c = IN_F(I_C); const float* cc = IN_F(I_CCTX); const float* wm = IN_F(I_WMOD); const float* bm = IN_F(I_BMOD); float* mod = (float*)(ws + WS_MOD);
        if (F.vcu < 96) {
            for (int idx = F.tid; idx < 5 * 1024; idx += NTHR) { const int j = idx >> 10, k = idx & 1023; const float v = j < 4 ? c[j * 1024 + k] : cc[k]; sc[idx] = v * sigmoidf_(v); }
            __syncthreads();
            for (int slab = F.vcu; slab < 96; slab += F.G) {
                const int kq = F.tid >> 6, cl = F.tid & 63, col = slab * 64 + cl;
                float acc[5] = {0.f, 0.f, 0.f, 0.f, 0.f};
#pragma unroll 8
                for (int k = kq * 128; k < kq * 128 + 128; ++k) { const float w = wm[(size_t)k * 6144 + col];
#pragma unroll
                    for (int j = 0; j < 5; ++j) acc[j] += sc[j * 1024 + k] * w; }
#pragma unroll
                for (int j = 0; j < 5; ++j) red[(kq * 5 + j) * 64 + cl] = acc[j];
                __syncthreads();
                if (F.tid < 320) { const int j = F.tid >> 6; float s = 0.f;
#pragma unroll
                    for (int q = 0; q < 8; ++q) s += red[(q * 5 + j) * 64 + cl];
                    mod[j * 6144 + col] = s + bm[col]; }
                __syncthreads();
            }
        }
        const int gt = F.vcu * NTHR + F.tid;
        if (gt < 1024) { const int pos = gt >> 4, fi = gt & 15; const float inv = exp2f(-(float)fi * (13.287712379549449f / 16.f)); const float ang = (float)pos * inv;
            float s, cs; sincosf(ang, &s, &cs); float* rp = (float*)(ws + WS_ROPE); rp[gt * 2] = cs; rp[gt * 2 + 1] = s; }
    }
    __syncthreads();
    const int gw = F.vcu * NWAVES + F.wave, NGW = F.G * NWAVES;
    {
        const float* lre = IN_F(I_LRE); const float* lim = IN_F(I_LIM); const float* lst = IN_F(I_LSTEP);
        const float* bre = IN_F(I_BRE); const float* bim = IN_F(I_BIM); const float* cre = IN_F(I_CRE); const float* cim = IN_F(I_CIM); const float* sd = IN_F(I_SD);
        bf16_t* BTY = (bf16_t*)(ws + WS_BTY); bf16_t* BTL = (bf16_t*)(ws + WS_BTL);
        LAS float* wl = (LAS float*)F.lds + F.wave * 256;
        const int p = F.lane;
        constexpr int NT_ITEMS = 32 * 63, NE_ITEMS = 32 * 32, NF_ITEMS = 32 * 32;
        for (int it = gw; it < NT_ITEMS + NE_ITEMS + NF_ITEMS; it += NGW) {
            if (it < NT_ITEMS) {
                const int g = it / 63, ds = it % 63 - 31, d = ds < 0 ? -ds : ds;
#pragma unroll
                for (int dir = 0; dir < 2; ++dir) {
                    const float lr = lre[(dir * 32 + g) * 64 + p], li = lim[(dir * 32 + g) * 64 + p], dt = expf(lst[dir * 32 + g]);
                    const Cx w = cmul(apow(lr, li, dt, (float)d), s5coef(lr, li, dt));
                    wl[(dir * 64 + p) * 2] = w.re; wl[(dir * 64 + p) * 2 + 1] = w.im;
                }
                LDS_WAIT(); asm volatile("" ::: "memory");
                const int h = F.lane >> 2, hp0 = (F.lane & 3) * 4;
                float kv[4] = {0.f, 0.f, 0.f, 0.f};
#pragma unroll
                for (int dir = 0; dir < 2; ++dir) {
                    if ((dir == 0 && ds < 0) || (dir == 1 && ds > 0)) continue;
                    const float* cr = cre + ((size_t)(dir * 32 + g) * 16 + h) * 64; const float* ci = cim + ((size_t)(dir * 32 + g) * 16 + h) * 64;
                    const float* br = bre + (size_t)(dir * 32 + g) * 64 * 16 + hp0; const float* bi = bim + (size_t)(dir * 32 + g) * 64 * 16 + hp0;
                    for (int q = 0; q < 64; ++q) {
                        const float wr_ = wl[(dir * 64 + q) * 2], wi_ = wl[(dir * 64 + q) * 2 + 1];
                        const float c_r = cr[q], c_i = ci[q]; const float xr = c_r * wr_ - c_i * wi_, xi = c_r * wi_ + c_i * wr_;
                        const f32x4 b_r = *(const f32x4*)(br + q * 16), b_i = *(const f32x4*)(bi + q * 16);
#pragma unroll
                        for (int e = 0; e < 4; ++e) kv[e] += xr * b_r[e] - xi * b_i[e];
                    }
                }
                if (ds == 0) {
#pragma unroll
                    for (int e = 0; e < 4; ++e) if (hp0 + e == h) kv[e] += sd[g * 16 + h]; }
                u32x2 w2; w2.x = cvtpk(kv[0], kv[1]); w2.y = cvtpk(kv[2], kv[3]);
                for (int i = (ds > 0 ? d : 0); i < (ds < 0 ? 32 - d : 32); ++i) { const int j = i - ds;
                    *(u32x2*)(BTY + ((size_t)(g * 512 + i * 16 + h) * SK + j * 16 + hp0)) = w2; }
                LDS_WAIT(); asm volatile("" ::: "memory");
            } else if (it < NT_ITEMS + NE_ITEMS) {
                const int e2 = it - NT_ITEMS, g = e2 >> 5, i = e2 & 31;
#pragma unroll
                for (int dir = 0; dir < 2; ++dir) {
                    const float lr = lre[(dir * 32 + g) * 64 + p], li = lim[(dir * 32 + g) * 64 + p], dt = expf(lst[dir * 32 + g]);
                    const Cx a = apow(lr, li, dt, dir == 0 ? (float)(i + 1) : (float)(32 - i));
                    for (int h = 0; h < 16; ++h) {
                        const Cx cc = Cx{cre[((size_t)(dir * 32 + g) * 16 + h) * 64 + p], cim[((size_t)(dir * 32 + g) * 16 + h) * 64 + p]};
                        const Cx ev = cmul(cc, a);
                        bf16_t* rowp = BTY + (size_t)(g * 512 + i * 16 + h) * SK + 512 + dir * 128 + p;
                        rowp[0] = (bf16_t)(cvtpk(ev.re, 0.f) & 0xffffu); rowp[64] = (bf16_t)(cvtpk(-ev.im, 0.f) & 0xffffu);
                    }
                }
            } else {
                const int f2 = it - NT_ITEMS - NE_ITEMS, g = f2 >> 5, j = f2 & 31;
#pragma unroll
                for (int dir = 0; dir < 2; ++dir) {
                    const float lr = lre[(dir * 32 + g) * 64 + p], li = lim[(dir * 32 + g) * 64 + p], dt = expf(lst[dir * 32 + g]);
                    const Cx w = cmul(apow(lr, li, dt, dir == 0 ? (float)(31 - j) : (float)j), s5coef(lr, li, dt));
                    const float* br = bre + ((size_t)(dir * 32 + g) * 64 + p) * 16; const float* bi = bim + ((size_t)(dir * 32 + g) * 64 + p) * 16;
                    float fr_[16], fi_[16];
#pragma unroll
                    for (int q4 = 0; q4 < 4; ++q4) { const f32x4 b_r = *(const f32x4*)(br + q4 * 4), b_i = *(const f32x4*)(bi + q4 * 4);
#pragma unroll
                        for (int e = 0; e < 4; ++e) { fr_[q4 * 4 + e] = w.re * b_r[e] - w.im * b_i[e]; fi_[q4 * 4 + e] = w.re * b_i[e] + w.im * b_r[e]; } }
                    bf16_t* r0 = BTL + ((size_t)(g * 256 + dir * 128 + p) * 512 + j * 16); bf16_t* r1 = r0 + (size_t)64 * 512;
                    u32x4 o;
                    o.x = cvtpk(fr_[0], fr_[1]); o.y = cvtpk(fr_[2], fr_[3]); o.z = cvtpk(fr_[4], fr_[5]); o.w = cvtpk(fr_[6], fr_[7]); *(u32x4*)r0 = o;
                    o.x = cvtpk(fr_[8], fr_[9]); o.y = cvtpk(fr_[10], fr_[11]); o.z = cvtpk(fr_[12], fr_[13]); o.w = cvtpk(fr_[14], fr_[15]); *(u32x4*)(r0 + 8) = o;
                    o.x = cvtpk(fi_[0], fi_[1]); o.y = cvtpk(fi_[2], fi_[3]); o.z = cvtpk(fi_[4], fi_[5]); o.w = cvtpk(fi_[6], fi_[7]); *(u32x4*)r1 = o;
                    o.x = cvtpk(fi_[8], fi_[9]); o.y = cvtpk(fi_[10], fi_[11]); o.z = cvtpk(fi_[12], fi_[13]); o.w = cvtpk(fi_[14], fi_[15]); *(u32x4*)(r1 + 8) = o;
                }
            }
        }
    }
    __syncthreads();
    {
        LAS float* scr = (LAS float*)(F.lds + F.wave * 16384);
        constexpr int I0 = 16 * 104, I1 = 8 * 16, I2 = 8 * 32, I3 = 8 * 32, I4 = 16 * 32, I5 = 32 * 16 * 64, I6 = 32 * 16 * 32;
        constexpr int NITEMS = I0 + I1 + I2 + I3 + I4 + I5 + I6;
        for (int it = gw; it < NITEMS; it += NGW) {
            int r = it;
            if (r < I5) { const int e = r >> 10; transpose_item<2>(IN_F(I_WGU) + (size_t)e * 1024 * 2048, 1024, 2048, (bf16_t*)(ws + WS_WGUT) + (size_t)e * 2048 * 1024, scr, r & 1023, F.lane); continue; } r -= I5;
            if (r < I6) { const int e = r >> 9; transpose_item<0>(IN_F(I_WD) + (size_t)e * 1024 * 1024, 1024, 1024, (bf16_t*)(ws + WS_WDT) + (size_t)e * 1024 * 1024, scr, r & 511, F.lane); continue; } r -= I6;
            if (r < I0) { transpose_item<1>(IN_F(I_WIN), 1024, INC, (bf16_t*)(ws + WS_WINT), scr, r, F.lane); continue; } r -= I0;
            if (r < I1) { transpose_item<0>(IN_F(I_WGLU), 512, 512, (bf16_t*)(ws + WS_WGLUT), scr, r, F.lane); continue; } r -= I1;
            if (r < I2) { transpose_item<0>(IN_F(I_WSO), 512, 1024, (bf16_t*)(ws + WS_WSOT), scr, r, F.lane); continue; } r -= I2;
            if (r < I3) { transpose_item<0>(IN_F(I_WAO), 512, 1024, (bf16_t*)(ws + WS_WAOT), scr, r, F.lane); continue; } r -= I3;
            transpose_item<0>(IN_F(I_WO), 1024, 1024, (bf16_t*)(ws + WS_WOT), scr, r, F.lane);
        }
    }
}

__device__ __forceinline__ void p1_lnmod(const Args& args, Frame& F) {
    const float* lg = IN_F(I_LNG); const float* lb = IN_F(I_LNB); const float* mod = (const float*)(F.ws + WS_MOD);
    float* st0 = (float*)(F.ws + WS_ST0); bf16_t* U = (bf16_t*)(F.ws + WS_U);
    const int gw = F.vcu * NWAVES + F.wave, NGW = F.G * NWAVES;
    for (int r = gw; r < MALL; r += NGW) {
        const float* src = r < MTOK ? IN_F(I_X) + (size_t)r * D : IN_F(I_CTX) + (size_t)(r - MTOK) * D;
        const int mj = r < MTOK ? (r >> 12) : 4;
        const f32x4* xr = (const f32x4*)src + F.lane;
        f32x4 v[4]; float s = 0.f;
#pragma unroll
        for (int j = 0; j < 4; ++j) { v[j] = xr[64 * j]; s += (v[j][0] + v[j][1]) + (v[j][2] + v[j][3]); }
        const float mean = wave_sum(s) * (1.f / D); float s2 = 0.f;
#pragma unroll
        for (int j = 0; j < 4; ++j) { v[j] = v[j] - mean; s2 += (v[j][0] * v[j][0] + v[j][1] * v[j][1]) + (v[j][2] * v[j][2] + v[j][3] * v[j][3]); }
        const float rstd = 1.f / sqrtf(wave_sum(s2) * (1.f / D) + LN_EPS);
        if (F.lane == 0) { st0[r * 2] = mean; st0[r * 2 + 1] = rstd; }
        const f32x4* sh = (const f32x4*)(mod + mj * 6144) + F.lane; const f32x4* sc = (const f32x4*)(mod + mj * 6144 + 1024) + F.lane;
        const f32x4* g4 = (const f32x4*)lg + F.lane; const f32x4* b4 = (const f32x4*)lb + F.lane;
        u32x2* o8 = (u32x2*)(U + (size_t)r * D) + F.lane;
#pragma unroll
        for (int j = 0; j < 4; ++j) { const f32x4 h = v[j] * rstd * g4[64 * j] + b4[64 * j]; const f32x4 u = h * (sc[64 * j] + 1.f) + sh[64 * j];
            u32x2 w; w.x = cvtpk(u[0], u[1]); w.y = cvtpk(u[2], u[3]); o8[64 * j] = w; }
    }
}

__device__ __forceinline__ int crow16(int r, int hi) { return (r & 3) + 8 * (r >> 2) + 4 * hi; }
__device__ __forceinline__ void attn_phase(const Args& args, Frame& F) {
    const bf16_t* Q = (const bf16_t*)(F.ws + WS_Q); const bf16_t* KB = (const bf16_t*)(F.ws + WS_KB); const bf16_t* VB = (const bf16_t*)(F.ws + WS_VB);
    bf16_t* OA = (bf16_t*)(F.ws + WS_OATT); const float* sink = IN_F(I_SINK);
    LAS unsigned char* Ks = F.lds; LAS unsigned char* Vt = F.lds + 9216; LAS float* wsf = (LAS float*)(F.lds + 17920) + F.wave * 64;
    const int lane = F.lane, r = lane & 31, hi = lane >> 5, wave = F.wave, tid = F.tid;
    const int key = tid >> 3, ch = tid & 7;
    for (int unit = F.vcu; unit < 256; unit += F.G) {
        const int nb = unit & 31, kvh = (unit >> 5) & 1, b = unit >> 6;
        const int q0 = nb * 128, head = kvh * 4 + (wave >> 1), qs = q0 + (wave & 1) * 64;
        bf16x8 qf[2][4];
#pragma unroll
        for (int g2 = 0; g2 < 2; ++g2)
#pragma unroll
            for (int s = 0; s < 4; ++s) qf[g2][s] = *(const bf16x8*)(Q + ((size_t)(b * SEQ + qs + g2 * 32 + r) * 512 + head * 64 + s * 16 + hi * 8));
        float mrun[2], lrun[2]; f32x16 o[2][2];
#pragma unroll
        for (int g2 = 0; g2 < 2; ++g2) { mrun[g2] = sink[head] * LOG2E; lrun[g2] = hi == 0 ? 1.f : 0.f; o[g2][0] = f32x16{}; o[g2][1] = f32x16{}; }
        int tt = 0;
        u32x4 kreg, vreg;
        { const size_t row = (size_t)(MTOK + b * CTX + key); kreg = *(const u32x4*)(KB + row * 128 + kvh * 64 + ch * 8); vreg = *(const u32x4*)(VB + row * 128 + kvh * 64 + ch * 8); }
        while (tt < 10) {
            __syncthreads();
            *(LAS u32x4*)(Ks + key * 144 + ch * 16) = kreg;
            { LAS unsigned short* vp = (LAS unsigned short*)(Vt + (ch * 8) * 136 + key * 2);
              vp[0 * 68] = (unsigned short)(vreg.x & 0xffffu); vp[1 * 68] = (unsigned short)(vreg.x >> 16); vp[2 * 68] = (unsigned short)(vreg.y & 0xffffu); vp[3 * 68] = (unsigned short)(vreg.y >> 16);
              vp[4 * 68] = (unsigned short)(vreg.z & 0xffffu); vp[5 * 68] = (unsigned short)(vreg.z >> 16); vp[6 * 68] = (unsigned short)(vreg.w & 0xffffu); vp[7 * 68] = (unsigned short)(vreg.w >> 16); }
            __syncthreads();
            const int cur = tt; const bool masked = cur >= 4; const int j0 = q0 - 128 + (cur - 4) * 64;
            int nx = cur + 1;
            while (nx < 10) { const int jn = q0 - 128 + (nx - 4) * 64; if (nx < 4 || (jn >= 0 && jn < SEQ)) break; ++nx; }
            if (nx < 10) { const size_t row = nx < 4 ? (size_t)(MTOK + b * CTX + nx * 64 + key) : (size_t)(b * SEQ + q0 - 128 + (nx - 4) * 64 + key);
                kreg = *(const u32x4*)(KB + row * 128 + kvh * 64 + ch * 8); vreg = *(const u32x4*)(VB + row * 128 + kvh * 64 + ch * 8); }
            tt = nx;
#pragma unroll
            for (int g2 = 0; g2 < 2; ++g2) {
                f32x16 p0 = f32x16{}, p1 = f32x16{};
#pragma unroll
                for (int s = 0; s < 4; ++s) {
                    const bf16x8 kf0 = *(const LAS bf16x8*)(Ks + r * 144 + (s * 16 + hi * 8) * 2), kf1 = *(const LAS bf16x8*)(Ks + (32 + r) * 144 + (s * 16 + hi * 8) * 2);
                    p0 = __builtin_amdgcn_mfma_f32_32x32x16_bf16(kf0, qf[g2][s], p0, 0, 0, 0); p1 = __builtin_amdgcn_mfma_f32_32x32x16_bf16(kf1, qf[g2][s], p1, 0, 0, 0);
                }
                if (masked) { const int qpos = qs + g2 * 32 + r;
#pragma unroll
                    for (int e = 0; e < 16; ++e) { const int d0 = j0 + crow16(e, hi) - qpos; if (d0 > 128 || d0 < -128) p0[e] = -1e30f; const int d1 = d0 + 32; if (d1 > 128 || d1 < -128) p1[e] = -1e30f; } }
                float tm = fmaxf(p0[0], p1[0]);
#pragma unroll
                for (int e = 1; e < 16; ++e) tm = fmaxf(tm, fmaxf(p0[e], p1[e]));
                tm = fmaxf(tm, __shfl_xor(tm, 32));
                const float mn = fmaxf(mrun[g2], tm); const float alpha = __builtin_amdgcn_exp2f(mrun[g2] - mn); mrun[g2] = mn;
                float rs = 0.f;
#pragma unroll
                for (int e = 0; e < 16; ++e) { p0[e] = __builtin_amdgcn_exp2f(p0[e] - mn); p1[e] = __builtin_amdgcn_exp2f(p1[e] - mn); rs += p0[e] + p1[e]; }
                lrun[g2] = lrun[g2] * alpha + rs;
                if (hi == 0) wsf[g2 * 32 + r] = alpha;
#pragma unroll
                for (int e = 0; e < 16; ++e) { const float a = wsf[g2 * 32 + crow16(e, hi)]; o[g2][0][e] *= a; o[g2][1][e] *= a; }
                u32x4 pw[4];
#pragma unroll
                for (int q4 = 0; q4 < 4; ++q4) { pw[0][q4] = cvtpk(p0[2 * q4], p0[2 * q4 + 1]); pw[1][q4] = cvtpk(p0[8 + 2 * q4], p0[8 + 2 * q4 + 1]); pw[2][q4] = cvtpk(p1[2 * q4], p1[2 * q4 + 1]); pw[3][q4] = cvtpk(p1[8 + 2 * q4], p1[8 + 2 * q4 + 1]); }
#pragma unroll
                for (int dh = 0; dh < 2; ++dh)
#pragma unroll
                    for (int s = 0; s < 4; ++s) { const int kb = 16 * (s & 1) + 32 * (s >> 1);
                        const u32x2 lo = *(const LAS u32x2*)(Vt + (dh * 32 + r) * 136 + (kb + 4 * hi) * 2), h2 = *(const LAS u32x2*)(Vt + (dh * 32 + r) * 136 + (kb + 8 + 4 * hi) * 2);
                        const u32x4 vv = {lo.x, lo.y, h2.x, h2.y};
                        o[g2][dh] = __builtin_amdgcn_mfma_f32_32x32x16_bf16(__builtin_bit_cast(bf16x8, pw[s]), __builtin_bit_cast(bf16x8, vv), o[g2][dh], 0, 0, 0); }
            }
        }
#pragma unroll
        for (int g2 = 0; g2 < 2; ++g2) {
            const float lt = lrun[g2] + __shfl_xor(lrun[g2], 32);
            if (hi == 0) wsf[g2 * 32 + r] = 1.f / lt;
#pragma unroll
            for (int e = 0; e < 16; ++e) { const float a = wsf[g2 * 32 + crow16(e, hi)];
                bf16_t* op = OA + ((size_t)(b * SEQ + qs + g2 * 32 + crow16(e, hi)) * 512 + head * 64 + r);
                op[0] = (bf16_t)(cvtpk(o[g2][0][e] * a, 0.f) & 0xffffu); op[32] = (bf16_t)(cvtpk(o[g2][1][e] * a, 0.f) & 0xffffu); }
        }
    }
    __syncthreads();
}

__device__ __forceinline__ void scan_phase(const Args& args, Frame& F) {
    if (F.tid >= 64) return;
    const int gt = F.vcu * 64 + F.tid; if (gt >= NB * SG * 128) return;
    const int q = gt & 127, dir = q >> 6, p = q & 63, g = (gt >> 7) & 31, b = gt >> 12;
    const float* L = (const float*)(F.ws + WS_LBUF) + (size_t)g * SROWS * 256 + dir * 128 + p;
    bf16_t* AP = (bf16_t*)(F.ws + WS_AP) + (size_t)g * SROWS * SK + 512 + dir * 128 + p;
    const float lr = IN_F(I_LRE)[(dir * 32 + g) * 64 + p], li = IN_F(I_LIM)[(dir * 32 + g) * 64 + p], dt = expf(IN_F(I_LSTEP)[dir * 32 + g]);
    const Cx a32 = apow(lr, li, dt, 32.f);
    Cx S = Cx{0.f, 0.f};
    if (dir == 0) {
        for (int cc = 0; cc < 8; ++cc) { const float* lp = L + (size_t)(512 + b * 8 + cc) * 256; const Cx t = cmul(a32, S); S = Cx{t.re + lp[0], t.im + lp[64]}; }
        for (int c = 0; c < 128; ++c) { const int row = b * 128 + c; bf16_t* ap = AP + (size_t)row * SK; ap[0] = (bf16_t)(cvtpk(S.re, 0.f) & 0xffffu); ap[64] = (bf16_t)(cvtpk(S.im, 0.f) & 0xffffu);
            const float* lp = L + (size_t)row * 256; const Cx t = cmul(a32, S); S = Cx{t.re + lp[0], t.im + lp[64]}; }
    } else {
        for (int cc = 7; cc >= 0; --cc) { const float* lp = L + (size_t)(512 + b * 8 + cc) * 256; const Cx t = cmul(a32, S); S = Cx{t.re + lp[0], t.im + lp[64]}; }
        for (int c = 127; c >= 0; --c) { const int row = b * 128 + c; bf16_t* ap = AP + (size_t)row * SK; ap[0] = (bf16_t)(cvtpk(S.re, 0.f) & 0xffffu); ap[64] = (bf16_t)(cvtpk(S.im, 0.f) & 0xffffu);
            const float* lp = L + (size_t)row * 256; const Cx t = cmul(a32, S); S = Cx{t.re + lp[0], t.im + lp[64]}; }
    }
}

__device__ __forceinline__ void router_phase(const Args& args, Frame& F) {
    unsigned char* ws = F.ws;
    LAS float* wT = (LAS float*)F.lds;
    volatile LAS int* cnt = F.MISC + 128; volatile LAS int* base = F.MISC + 160; volatile LAS int* rinfo = F.MISC + 256;
    LAS float* rgate = (LAS float*)(F.MISC + 512);
    const float* wr = IN_F(I_WR);
    for (int idx = F.tid; idx < 32 * 1024; idx += NTHR) { const int k = idx >> 5, e = idx & 31; wT[e * 1024 + k] = wr[idx]; }
    if (F.tid < 32) cnt[F.tid] = 0;
    __syncthreads();
    const float* R1 = (const float*)(ws + WS_R1); float* st1 = (float*)(ws + WS_ST1); bf16_t* XF = (bf16_t*)(ws + WS_XF);
    const float* mod = (const float*)(ws + WS_MOD); const float* l1g = IN_F(I_LN1G); const float* l1b = IN_F(I_LN1B); const float* brt = IN_F(I_BR);
    int* toke = (int*)(ws + WS_TOKE); float* tokg = (float*)(ws + WS_TOKG); int* tokp = (int*)(ws + WS_TOKP);
    const int lane = F.lane;
    const int rows_per_blk = MTOK / F.G;
    const int row_base = F.vcu * rows_per_blk;
    for (int rl = F.wave * 2; rl < rows_per_blk; rl += NWAVES * 2) {
        f32x4 xv[2][4];
#pragma unroll
        for (int rr = 0; rr < 2; ++rr) {
            const int row = row_base + rl + rr; const int b = row >> 12;
            const f32x4* xr = (const f32x4*)(R1 + (size_t)row * D) + lane;
            f32x4 v[4]; float s = 0.f;
#pragma unroll
            for (int j = 0; j < 4; ++j) { v[j] = xr[64 * j]; s += (v[j][0] + v[j][1]) + (v[j][2] + v[j][3]); }
            const float mean = wave_sum(s) * (1.f / D); float s2 = 0.f;
#pragma unroll
            for (int j = 0; j < 4; ++j) { v[j] = v[j] - mean; s2 += (v[j][0] * v[j][0] + v[j][1] * v[j][1]) + (v[j][2] * v[j][2] + v[j][3] * v[j][3]); }
            const float rstd = 1.f / sqrtf(wave_sum(s2) * (1.f / D) + LN_EPS);
            if (lane == 0) { st1[row * 2] = mean; st1[row * 2 + 1] = rstd; }
            const f32x4* sh = (const f32x4*)(mod + b * 6144 + 3 * 1024) + lane; const f32x4* sc = (const f32x4*)(mod + b * 6144 + 4 * 1024) + lane;
            const f32x4* g4 = (const f32x4*)l1g + lane; const f32x4* b4 = (const f32x4*)l1b + lane;
            u32x2* o8 = (u32x2*)(XF + (size_t)row * D) + lane;
#pragma unroll
            for (int j = 0; j < 4; ++j) { const f32x4 h = v[j] * rstd * g4[64 * j] + b4[64 * j]; const f32x4 u = h * (sc[64 * j] + 1.f) + sh[64 * j]; xv[rr][j] = u;
                u32x2 w; w.x = cvtpk(u[0], u[1]); w.y = cvtpk(u[2], u[3]); o8[64 * j] = w; }
        }
        float lg0[32], lg1[32];
#pragma unroll
        for (int e = 0; e < 32; ++e) {
            float a0 = 0.f, a1 = 0.f;
#pragma unroll
            for (int j = 0; j < 4; ++j) { const f32x4 w = *(const LAS f32x4*)(wT + e * 1024 + 256 * j + 4 * lane);
                a0 += (xv[0][j][0] * w[0] + xv[0][j][1] * w[1]) + (xv[0][j][2] * w[2] + xv[0][j][3] * w[3]);
                a1 += (xv[1][j][0] * w[0] + xv[1][j][1] * w[1]) + (xv[1][j][2] * w[2] + xv[1][j][3] * w[3]); }
            lg0[e] = wave_sum(a0) + brt[e]; lg1[e] = wave_sum(a1) + brt[e];
        }
#pragma unroll
        for (int rr = 0; rr < 2; ++rr) {
            const int row = row_base + rl + rr;
            int te[4]; float tv[4];
#pragma unroll
            for (int k = 0; k < 4; ++k) {
                float best = -3.0e38f; int bi = 0;
#pragma unroll
                for (int e = 0; e < 32; ++e) { const float v = rr == 0 ? lg0[e] : lg1[e]; if (v > best) { best = v; bi = e; } }
#pragma unroll
                for (int e = 0; e < 32; ++e) { if (e == bi) { if (rr == 0) lg0[e] = -3.0e38f; else lg1[e] = -3.0e38f; } }
                te[k] = bi; tv[k] = best;
            }
            const float e1 = __expf(tv[1] - tv[0]), e2 = __expf(tv[2] - tv[0]), e3 = __expf(tv[3] - tv[0]); const float inv = 1.f / (1.f + e1 + e2 + e3);
            const float gk[4] = {inv, e1 * inv, e2 * inv, e3 * inv};
            if (lane < 4) {
                const int k = lane; const int e = k == 0 ? te[0] : k == 1 ? te[1] : k == 2 ? te[2] : te[3]; const float gv = k == 0 ? gk[0] : k == 1 ? gk[1] : k == 2 ? gk[2] : gk[3];
                const int pl = atomicAdd((int*)&cnt[e], 1);
                rinfo[(rl + rr) * 4 + k] = e | (pl << 8); rgate[(rl + rr) * 4 + k] = gv;
                toke[row * 4 + k] = e; tokg[row * 4 + k] = gv;
            }
        }
    }
    __syncthreads();
    if (F.tid < 32) base[F.tid] = (int)atomicAdd((unsigned*)(ws + WS_CTL) + CW_GCNT + F.tid, (unsigned)cnt[F.tid]);
    __syncthreads();
    if (F.tid < rows_per_blk * 4) {
        const int inf = rinfo[F.tid], e = inf & 255, pos = base[e] + (inf >> 8); const int row = row_base + (F.tid >> 2);
        ((int*)(ws + WS_LIST))[(size_t)e * LCAP + pos] = row; ((float*)(ws + WS_LGATE))[(size_t)e * LCAP + pos] = rgate[F.tid]; tokp[row * 4 + (F.tid & 3)] = pos;
    }
    __syncthreads();
}

__device__ __forceinline__ void moe_tab(Frame& F) {
    __syncthreads();
    if (F.tid == 0) { const unsigned* gc = (const unsigned*)(F.ws + WS_CTL) + CW_GCNT; int acc = 0;
        for (int e = 0; e < 32; ++e) { const int c = (int)__hip_atomic_load(gc + e, __ATOMIC_RELAXED, __HIP_MEMORY_SCOPE_AGENT); F.MISC[e] = acc; F.MISC[64 + e] = c; acc += (c + 255) >> 8; }
        F.MISC[32] = acc; }
    __syncthreads();
}

__device__ __forceinline__ void combine_phase(const Args& args, Frame& F) {
    unsigned char* ws = F.ws;
    const float* R1 = (const float*)(ws + WS_R1); const float* st1 = (const float*)(ws + WS_ST1); const bf16_t* YR = (const bf16_t*)(ws + WS_YR);
    const int* toke = (const int*)(ws + WS_TOKE); const int* tokp = (const int*)(ws + WS_TOKP); const float* mod = (const float*)(ws + WS_MOD);
    const float* l1g = IN_F(I_LN1G); const float* l1b = IN_F(I_LN1B); const float* l2g = IN_F(I_LN2G); const float* l2b = IN_F(I_LN2B);
    const int lane = F.lane; const int gw = F.vcu * NWAVES + F.wave, NGW = F.G * NWAVES;
    for (int row = gw; row < MTOK; row += NGW) {
        const int b = row >> 12; const float mean1 = st1[row * 2], rstd1 = st1[row * 2 + 1];
        f32x4 ff[4] = {f32x4{}, f32x4{}, f32x4{}, f32x4{}};
#pragma unroll
        for (int k = 0; k < 4; ++k) { const int e = toke[row * 4 + k], pos = tokp[row * 4 + k]; const size_t hr = (size_t)F.MISC[e] * 256 + pos;
            const u32x2* yp = (const u32x2*)(YR + hr * 1024) + lane;
#pragma unroll
            for (int j = 0; j < 4; ++j) { const u32x2 w = yp[64 * j]; ff[j][0] += bflo(w.x); ff[j][1] += bfhi(w.x); ff[j][2] += bflo(w.y); ff[j][3] += bfhi(w.y); } }
        const f32x4* xr = (const f32x4*)(R1 + (size_t)row * D) + lane; const f32x4* g2 = (const f32x4*)(mod + b * 6144 + 5 * 1024) + lane;
        const f32x4* g4 = (const f32x4*)l1g + lane; const f32x4* b4 = (const f32x4*)l1b + lane;
        f32x4 v[4]; float s = 0.f;
#pragma unroll
        for (int j = 0; j < 4; ++j) { const f32x4 h = (xr[64 * j] - mean1) * rstd1 * g4[64 * j] + b4[64 * j]; v[j] = h * DN_ALPHA + g2[64 * j] * ff[j]; s += (v[j][0] + v[j][1]) + (v[j][2] + v[j][3]); }
        const float mean = wave_sum(s) * (1.f / D); float s2 = 0.f;
#pragma unroll
        for (int j = 0; j < 4; ++j) { v[j] = v[j] - mean; s2 += (v[j][0] * v[j][0] + v[j][1] * v[j][1]) + (v[j][2] * v[j][2] + v[j][3] * v[j][3]); }
        const float rstd = 1.f / sqrtf(wave_sum(s2) * (1.f / D) + LN_EPS);
        const f32x4* og = (const f32x4*)l2g + lane; const f32x4* ob = (const f32x4*)l2b + lane; f32x4* op = (f32x4*)(args.out + (size_t)row * D) + lane;
#pragma unroll
        for (int j = 0; j < 4; ++j) op[64 * j] = v[j] * rstd * og[64 * j] + ob[64 * j];
    }
}

constexpr int N_PHASES = 14;
__global__ void __launch_bounds__(NTHR, 2) fwd_kernel(Args args) {
    extern __shared__ __attribute__((aligned(16))) unsigned char lds_raw[];
    Frame F;
    F.lds = (LAS unsigned char*)lds_raw; F.MISC = (volatile LAS int*)(F.lds + MISC_OFF);
    F.tid = threadIdx.x; F.lane = F.tid & 63; F.wave = __builtin_amdgcn_readfirstlane(F.tid >> 6);
    F.G = gridDim.x; { const int bx = blockIdx.x; F.vcu = (F.G % 8 == 0) ? (bx % 8) * (F.G / 8) + bx / 8 : bx; }
    F.ws = args.ws; F.a = &args;
    unsigned char* ws = args.ws;
    const int lo = args.ph_lo, hi = args.ph_hi;
#define IN(k) (lo <= (k) && (k) < hi)
#if MK_MULTI
#define GRID_BAR(k) do { } while (0)
#else
    cg::grid_group grid = cg::this_grid();
#define GRID_BAR(k) do { if (IN((k) + 1)) grid.sync(); } while (0)
#endif
    if (IN(0)) { p0_prep(args, F); GRID_BAR(0); }
    if (IN(1)) { p1_lnmod(args, F); GRID_BAR(1); }
    if (IN(2)) {
        SchedG1 S{(const char*)(ws + WS_U), (const char*)(ws + WS_WINT), F.G, F.vcu};
        EpiG1 E{(bf16_t*)(ws + WS_AP), (bf16_t*)(ws + WS_Q), (bf16_t*)(ws + WS_KB), (bf16_t*)(ws + WS_VB), (bf16_t*)(ws + WS_SGB), (bf16_t*)(ws + WS_SAB), (const float*)(ws + WS_ROPE)};
        pg8::gemm_phase<EpiG1, SchedG1, true>(F.lds, 1024, 2048u, S, E);
        GRID_BAR(2);
    }
    if (IN(3)) { attn_phase(args, F); }
    if (IN(4)) {
        SchedS5L S{(const char*)(ws + WS_AP), (const char*)(ws + WS_BTL), F.G, F.vcu};
        EpiS5L E{(float*)(ws + WS_LBUF)};
        pg8::gemm_phase<EpiS5L, SchedS5L, true>(F.lds, 512, (unsigned)(SK * 2), S, E);
        GRID_BAR(4);
    }
    if (IN(5)) { scan_phase(args, F); GRID_BAR(5); }
    if (IN(6)) {
        SchedS5Y S{(const char*)(ws + WS_AP), (const char*)(ws + WS_BTY), F.G, F.vcu};
        EpiS5Y E{(bf16_t*)(ws + WS_Z)};
        pg8::gemm_phase<EpiS5Y, SchedS5Y, true>(F.lds, 768, (unsigned)(SK * 2), S, E);
        GRID_BAR(6);
    }
    if (IN(7)) {
        SchedPlain S{(const char*)(ws + WS_Z), (const char*)(ws + WS_WGLUT), 64, 2, 512, F.G, F.vcu};
        EpiGLU E{(const bf16_t*)(ws + WS_Z), (bf16_t*)(ws + WS_Z2), IN_F(I_BGLU)};
        pg8::gemm_phase<EpiGLU, SchedPlain, true>(F.lds, 512, 1024u, S, E);
        GRID_BAR(7);
    }
    if (IN(8)) {
        SchedMerge S{(const char*)(ws + WS_Z2), (const char*)(ws + WS_OATT), (const char*)(ws + WS_WSOT), (const char*)(ws + WS_WAOT), F.G, F.vcu};
        EpiMerge E{(const bf16_t*)(ws + WS_SGB), (const bf16_t*)(ws + WS_SAB), (float*)(ws + WS_TMP), (bf16_t*)(ws + WS_MB)};
        pg8::gemm_phase<EpiMerge, SchedMerge, true>(F.lds, 512, 1024u, S, E);
        GRID_BAR(8);
    }
    if (IN(9)) {
        SchedPlain S{(const char*)(ws + WS_MB), (const char*)(ws + WS_WOT), 64, 4, 1024, F.G, F.vcu};
        EpiWO E{IN_F(I_X), (const float*)(ws + WS_ST0), IN_F(I_LNG), IN_F(I_LNB), (const float*)(ws + WS_MOD), (float*)(ws + WS_R1)};
        pg8::gemm_phase<EpiWO, SchedPlain, true>(F.lds, 1024, 2048u, S, E);
        GRID_BAR(9);
    }
    if (IN(10)) { router_phase(args, F); GRID_BAR(10); }
    if (IN(11)) {
        moe_tab(F);
        SchedMoe<8, true> S{(const char*)(ws + WS_XF), (const char*)(ws + WS_WGUT), (const int*)(ws + WS_LIST), MoeTab{F.MISC}, F.G, F.vcu};
        EpiMoe1 E{(bf16_t*)(ws + WS_H), IN_F(I_BGU)};
        pg8::gemm_phase<EpiMoe1, SchedMoe<8, true>, true>(F.lds, 1024, 2048u, S, E);
        GRID_BAR(11);
    }
    if (IN(12)) {
        moe_tab(F);
        SchedMoe<4, false> S{(const char*)(ws + WS_H), (const char*)(ws + WS_WDT), (const int*)(ws + WS_LIST), MoeTab{F.MISC}, F.G, F.vcu};
        EpiMoe2 E{(bf16_t*)(ws + WS_YR), IN_F(I_BD), (const float*)(ws + WS_LGATE), MoeTab{F.MISC}};
        pg8::gemm_phase<EpiMoe2, SchedMoe<4, false>, true>(F.lds, 1024, 2048u, S, E);
        GRID_BAR(12);
    }
    if (IN(13)) { moe_tab(F); combine_phase(args, F); }
#undef IN
#undef GRID_BAR
}

extern "C" void kernel_launch(void* const* d_in, const int* in_sizes, int n_in, void* d_out, int out_size, void* d_ws, size_t ws_size, hipStream_t stream) {
    static int grid = 0;
    if (grid == 0) {
        if (n_in != 33 || in_sizes[0] != MTOK * D || out_size != MTOK * D || ws_size < WS_END) { fprintf(stderr, "kernel_launch: unexpected shapes (n_in %d, ws %zu)\n", n_in, ws_size); grid = -1; return; }
        int dev = 0, cus = 0, per_cu = 0;
        if (hipGetDevice(&dev) != hipSuccess || hipDeviceGetAttribute(&cus, hipDeviceAttributeMultiprocessorCount, dev) != hipSuccess) { grid = -1; return; }
        if (hipFuncSetAttribute((const void*)fwd_kernel, hipFuncAttributeMaxDynamicSharedMemorySize, LDS_BYTES) != hipSuccess) { fprintf(stderr, "kernel_launch: hipFuncSetAttribute failed\n"); grid = -1; return; }
        if (hipOccupancyMaxActiveBlocksPerMultiprocessor(&per_cu, (const void*)fwd_kernel, NTHR, LDS_BYTES) != hipSuccess || per_cu < 1) { fprintf(stderr, "kernel_launch: occupancy query says %d\n", per_cu); (void)hipGetLastError(); grid = -1; return; }
        if (cus < 256) { fprintf(stderr, "kernel_launch: needs 256 CUs, device has %d\n", cus); grid = -1; return; }
        grid = 256;
    }
    if (grid < 0) return;
    (void)hipMemsetAsync((char*)d_ws + WS_CTL, 0, CTL_BYTES, stream);
    Args a{};
    for (int i = 0; i < 33; ++i) a.in[i] = d_in[i];
    a.out = (float*)d_out; a.ws = (unsigned char*)d_ws;
#if MK_MULTI
    for (int p = 0; p < N_PHASES; ++p) { a.ph_lo = p; a.ph_hi = p + 1; hipLaunchKernelGGL(fwd_kernel, dim3(grid), dim3(NTHR), LDS_BYTES, stream, a); }
#else
    a.ph_lo = 0; a.ph_hi = N_PHASES;
    void* kargs[] = {&a};
    hipError_t e = hipLaunchCooperativeKernel((const void*)fwd_kernel, dim3(grid), dim3(NTHR), kargs, LDS_BYTES, stream);
    if (e != hipSuccess) fprintf(stderr, "kernel_launch: cooperative launch failed: %s\n", hipGetErrorString(e));
#endif
}
```

```cpp
#include <hip/hip_runtime.h>
#include <hip/hip_cooperative_groups.h>
#include <cstdint>
#include <cstdio>
namespace cg = cooperative_groups;

#ifndef MK_MULTI
#define MK_MULTI 0
#endif

#define LAS __attribute__((address_space(3)))
#define GAS __attribute__((address_space(1)))
typedef unsigned short bf16_t;
typedef short bf16x8 __attribute__((ext_vector_type(8)));
typedef float f32x4 __attribute__((ext_vector_type(4)));
typedef float f32x2 __attribute__((ext_vector_type(2)));
typedef float f32x16 __attribute__((ext_vector_type(16)));
typedef unsigned u32x4 __attribute__((ext_vector_type(4)));
typedef unsigned u32x2 __attribute__((ext_vector_type(2)));
typedef __bf16 bf16x2_t __attribute__((ext_vector_type(2)));

constexpr int D = 1024, NB = 4, SEQ = 4096, CTX = 256;
constexpr int MTOK = NB * SEQ;
constexpr int MCTX = NB * CTX;
constexpr int MALL = MTOK + MCTX;
constexpr int INC = 3328;
constexpr int NE = 32, FE = 1024;
constexpr int SG = 32, SP = 64, SH = 16, CH = 32;
constexpr int SROWS = 768;
constexpr int SK = 768;
constexpr float LN_EPS = 1e-5f;
constexpr float DN_ALPHA = 1.189207115002721f;
constexpr float LOG2E = 1.4426950408889634f;
constexpr int LCAP = 16384;
constexpr int HCAP = 65536 + NE * 256;

constexpr size_t MiB = 1u << 20;
constexpr size_t WS_CTL = 0, CTL_BYTES = 1 * MiB;
constexpr size_t WS_MOD = 1 * MiB;
constexpr size_t WS_ROPE = 1 * MiB + 128 * 1024;
constexpr size_t WS_ST0 = 1 * MiB + 256 * 1024;
constexpr size_t WS_ST1 = 1 * MiB + 512 * 1024;
constexpr size_t WS_TOKE = 2 * MiB;
constexpr size_t WS_TOKP = 2 * MiB + 256 * 1024;
constexpr size_t WS_TOKG = 2 * MiB + 512 * 1024;
constexpr size_t WS_LIST = 3 * MiB;
constexpr size_t WS_LGATE = 5 * MiB;
constexpr size_t WS_WINT = 8 * MiB;
constexpr size_t WS_WGLUT = 15 * MiB;
constexpr size_t WS_WSOT = 16 * MiB;
constexpr size_t WS_WAOT = 17 * MiB;
constexpr size_t WS_WOT = 18 * MiB;
constexpr size_t WS_BTL = 20 * MiB;
constexpr size_t WS_BTY = 28 * MiB;
constexpr size_t WS_WGUT = 52 * MiB;
constexpr size_t WS_WDT = 180 * MiB;
constexpr size_t WS_R1 = 244 * MiB;
constexpr size_t WS_XF = 308 * MiB;
constexpr size_t WS_U = 340 * MiB;
constexpr size_t WS_AP = 374 * MiB;
constexpr size_t WS_Q = 410 * MiB;
constexpr size_t WS_KB = 426 * MiB;
constexpr size_t WS_VB = 431 * MiB;
constexpr size_t WS_SGB = 436 * MiB;
constexpr size_t WS_SAB = 468 * MiB;
constexpr size_t WS_LBUF = 500 * MiB;
constexpr size_t WS_Z = 524 * MiB;
constexpr size_t WS_Z2 = 540 * MiB;
constexpr size_t WS_OATT = 556 * MiB;
constexpr size_t WS_TMP = 572 * MiB;
constexpr size_t WS_MB = 636 * MiB;
constexpr size_t WS_H = 340 * MiB;
constexpr size_t WS_YR = 484 * MiB;
constexpr size_t WS_END = 668 * MiB;
static_assert(WS_H + (size_t)HCAP * 1024 * 2 <= WS_YR && WS_YR + (size_t)HCAP * 1024 * 2 <= WS_MB, "MoE overlay");
constexpr int CW_GCNT = 64;
constexpr int CW_BAR = 4096;

constexpr int RING_BYTES = 131072;
constexpr int MISC_OFF = RING_BYTES;
constexpr int LDS_BYTES = 147456;
constexpr int NWAVES = 8, NTHR = 512;

__device__ __forceinline__ unsigned cvtpk(float lo, float hi) { f32x2 v = {lo, hi}; bf16x2_t b = __builtin_convertvector(v, bf16x2_t); return __builtin_bit_cast(unsigned, b); }
__device__ __forceinline__ float bf2f(unsigned short h) { return __uint_as_float((unsigned)h << 16); }
__device__ __forceinline__ float bflo(unsigned w) { return __uint_as_float(w << 16); }
__device__ __forceinline__ float bfhi(unsigned w) { return __uint_as_float(w & 0xffff0000u); }
__device__ __forceinline__ float sigmoidf_(float v) { return __builtin_amdgcn_rcpf(1.f + __expf(-v)); }
__device__ __forceinline__ float wave_sum(float v) {
#pragma unroll
    for (int o = 1; o < 64; o <<= 1) v += __shfl_xor(v, o);
    return v;
}
#define LDS_WAIT() asm volatile("s_waitcnt lgkmcnt(0)" ::: "memory")
#define VM_WAIT() asm volatile("s_waitcnt vmcnt(0)" ::: "memory")

namespace pg8 {
constexpr int BM = 256, BK = 64, HALF = 128, HTB = HALF * BK * 2, STAGE_BYTES = 8 * HTB;
__device__ __forceinline__ int lds_byte(int r, int c) { const int st = (r >> 4) * 2 + (c >> 5), rr = r & 15, cc = c & 31, ob = rr * 64 + cc * 2; return st * 1024 + (ob ^ (((ob >> 9) & 1) << 5)); }
__device__ __forceinline__ void stage_rc(int b, int& R, int& C) { const int st = b / 1024, sb = b % 1024, swz = sb ^ (((sb >> 9) & 1) << 5); R = (st >> 1) * 16 + swz / 64; C = (st & 1) * 32 + (swz % 64) / 2; }
__device__ __forceinline__ int perm32(int rho) { const int n = rho >> 4, i = rho & 15; return 8 * (i >> 2) + 4 * n + (i & 3); }

struct Unit { const char* a; const char* b; int pm, pn, aux; };

template <class Epi, class Sched, bool ALIGN_EPI>
__device__ __forceinline__ void gemm_phase(LAS unsigned char* lds, const int K, const unsigned lda2, const Sched& S, const Epi& E) {
    const int tid = threadIdx.x, wid = __builtin_amdgcn_readfirstlane(tid >> 6), lane = tid & 63, wr = wid >> 2, wc = wid & 3, fr = lane & 15, fq = lane >> 4;
    const int nt = K / BK;
    int Rl[2], Cl[2]; unsigned voffB[2];
#pragma unroll
    for (int i = 0; i < 2; ++i) { stage_rc(tid * 16 + i * 8192, Rl[i], Cl[i]); const int Rb = Epi::PERM ? ((Rl[i] & ~31) + perm32(Rl[i] & 31)) : Rl[i]; voffB[i] = (unsigned)(Rb * K + Cl[i]) * 2u; }
    const size_t kstep = (size_t)(BK * 2);
    const size_t hstepB = (size_t)HALF * K * 2;
    const unsigned ldsw = (unsigned)wid * 1024u;
    const int aoff = lds_byte(wr * 64 + fr, fq * 8), boff = lds_byte(wc * 32 + fr, fq * 8);
#define PG8_SA(b, h) (((b) * 2 + (h)) * HTB)
#define PG8_SB(b, h) ((4 + (b) * 2 + (h)) * HTB)
#define PG8_STAGE(bufoff, gbase, v0, v1) do { \
        __builtin_amdgcn_global_load_lds((const unsigned*)((const char*)(gbase) + (v0)), (LAS unsigned*)(lds + (bufoff) + ldsw), 16, 0, 0); \
        __builtin_amdgcn_global_load_lds((const unsigned*)((const char*)(gbase) + (v1)), (LAS unsigned*)(lds + (bufoff) + ldsw + 8192), 16, 0, 0); } while (0)
#define PG8_STAGEB(bufoff, gbase) PG8_STAGE(bufoff, gbase, voffB[0], voffB[1])
#define PG8_LDA(dst, b, h) do { _Pragma("unroll") for (int m = 0; m < 4; ++m) _Pragma("unroll") for (int k = 0; k < 2; ++k) dst[m][k] = *(const LAS bf16x8*)(lds + PG8_SA(b, h) + aoff + m * 2048 + k * 1024); } while (0)
#define PG8_LDB(dst, b, h) do { _Pragma("unroll") for (int n = 0; n < 2; ++n) _Pragma("unroll") for (int k = 0; k < 2; ++k) dst[n][k] = *(const LAS bf16x8*)(lds + PG8_SB(b, h) + boff + n * 2048 + k * 1024); } while (0)
#define PG8_MMA(ai, bj, At, Bt) do { __builtin_amdgcn_s_setprio(1); _Pragma("unroll") for (int m = 0; m < 4; ++m) _Pragma("unroll") for (int n = 0; n < 2; ++n) _Pragma("unroll") for (int k = 0; k < 2; ++k) \
        acc[ai][bj][m][n] = __builtin_amdgcn_mfma_f32_16x16x32_bf16(Bt[n][k], At[m][k], acc[ai][bj][m][n], 0, 0, 0); __builtin_amdgcn_s_setprio(0); } while (0)
#define PG8_WAIT_V(n) asm volatile("s_waitcnt vmcnt(" #n ")" ::: "memory")
#define PG8_WAIT_L(n) asm volatile("s_waitcnt lgkmcnt(" #n ")" ::: "memory")
#define PG8_BAR __builtin_amdgcn_s_barrier()
#define PG8_SCHED __builtin_amdgcn_sched_barrier(0)
#define PG8_SETA(v, u) do { _Pragma("unroll") for (int h_ = 0; h_ < 2; ++h_) _Pragma("unroll") for (int i_ = 0; i_ < 2; ++i_) { \
        const unsigned row_ = Sched::GATHER ? S.arow(u, h_ * HALF + Rl[i_]) : (unsigned)(h_ * HALF + Rl[i_]); v[h_][i_] = row_ * lda2 + (unsigned)Cl[i_] * 2u; } } while (0)
    Unit cur, nxt; int ui = 0;
    if (!S.next(0, cur)) return;
    f32x4 acc[2][2][4][2];
#pragma unroll
    for (int a = 0; a < 2; ++a)
#pragma unroll
        for (int b = 0; b < 2; ++b)
#pragma unroll
            for (int m = 0; m < 4; ++m)
#pragma unroll
                for (int n = 0; n < 2; ++n) acc[a][b][m][n] = (f32x4){0.f, 0.f, 0.f, 0.f};
    bf16x8 At[4][2], B0[2][2], B1[2][2];
    unsigned vc[2][2], vn[2][2];
    PG8_SETA(vc, cur);
    const char* cA = cur.a; const char* cB = cur.b;
    PG8_STAGEB(PG8_SB(0, 0), cB); PG8_STAGEB(PG8_SB(0, 1), cB + hstepB); PG8_STAGE(PG8_SA(0, 0), cA, vc[0][0], vc[0][1]); PG8_STAGE(PG8_SA(0, 1), cA, vc[1][0], vc[1][1]);
    if (wr == 1) PG8_BAR;
    PG8_WAIT_V(2); PG8_BAR;
    PG8_STAGEB(PG8_SB(1, 0), cB + kstep); PG8_STAGE(PG8_SA(1, 0), cA + kstep, vc[0][0], vc[0][1]); PG8_STAGEB(PG8_SB(1, 1), cB + hstepB + kstep);
    PG8_WAIT_V(6); PG8_BAR;
    for (;;) {
        const bool has_next = S.next(ui + 1, nxt);
        const char* nA = has_next ? nxt.a : cA; const char* nB = has_next ? nxt.b : cB;
        if (Sched::GATHER) { if (has_next) { PG8_SETA(vn, nxt); } else {
#pragma unroll
            for (int h = 0; h < 2; ++h) { vn[h][0] = vc[h][0]; vn[h][1] = vc[h][1]; } } }
        for (int t = 0; t < nt; t += 2) {
            const bool last = (t == nt - 2);
            const char* a1 = cA + (size_t)(t + 1) * kstep;
            const char* a2 = last ? nA : cA + (size_t)(t + 2) * kstep; const char* b2 = last ? nB : cB + (size_t)(t + 2) * kstep;
            const char* a3 = a2 + kstep; const char* b3 = b2 + kstep;
            unsigned v2[2][2];
#pragma unroll
            for (int h = 0; h < 2; ++h) { v2[h][0] = (Sched::GATHER && last) ? vn[h][0] : vc[h][0]; v2[h][1] = (Sched::GATHER && last) ? vn[h][1] : vc[h][1]; }
            PG8_LDB(B0, 0, 0); PG8_LDB(B1, 0, 1); PG8_SCHED; PG8_LDA(At, 0, 0); PG8_STAGE(PG8_SA(1, 1), a1, vc[1][0], vc[1][1]);
            PG8_WAIT_V(8); PG8_WAIT_L(0); PG8_BAR; PG8_MMA(0, 0, At, B0); PG8_MMA(0, 1, At, B1); PG8_BAR; PG8_SCHED;
            PG8_LDA(At, 0, 1); PG8_STAGEB(PG8_SB(0, 0), b2); PG8_STAGEB(PG8_SB(0, 1), b2 + hstepB); PG8_STAGE(PG8_SA(0, 0), a2, v2[0][0], v2[0][1]);
            PG8_WAIT_V(8); PG8_WAIT_L(0); PG8_BAR; PG8_MMA(1, 0, At, B0); PG8_MMA(1, 1, At, B1); PG8_BAR; PG8_SCHED;
            PG8_LDB(B0, 1, 0); PG8_LDB(B1, 1, 1); PG8_SCHED; PG8_LDA(At, 1, 0); PG8_STAGE(PG8_SA(0, 1), a2, v2[1][0], v2[1][1]);
            PG8_WAIT_V(8); PG8_WAIT_L(0); PG8_BAR; PG8_MMA(0, 0, At, B0); PG8_MMA(0, 1, At, B1); PG8_BAR; PG8_SCHED;
            PG8_LDA(At, 1, 1); PG8_STAGEB(PG8_SB(1, 0), b3); PG8_STAGEB(PG8_SB(1, 1), b3 + hstepB); PG8_STAGE(PG8_SA(1, 0), a3, v2[0][0], v2[0][1]);
            PG8_WAIT_V(8); PG8_WAIT_L(0); PG8_BAR; PG8_MMA(1, 0, At, B0); PG8_MMA(1, 1, At, B1); PG8_BAR; PG8_SCHED;
        }
        if constexpr (ALIGN_EPI) { if (wr == 0) PG8_BAR; }
        E(acc, cur, wr, wc, fr, fq);
        if (!has_next) break;
#pragma unroll
        for (int a = 0; a < 2; ++a)
#pragma unroll
            for (int b = 0; b < 2; ++b)
#pragma unroll
                for (int m = 0; m < 4; ++m)
#pragma unroll
                    for (int n = 0; n < 2; ++n) acc[a][b][m][n] = (f32x4){0.f, 0.f, 0.f, 0.f};
        cur = nxt; cA = nA; cB = nB; ++ui;
        if (Sched::GATHER) {
#pragma unroll
            for (int h = 0; h < 2; ++h) { vc[h][0] = vn[h][0]; vc[h][1] = vn[h][1]; } }
        if constexpr (ALIGN_EPI) { if (wr == 1) PG8_BAR; }
    }
    PG8_WAIT_V(0);
    if constexpr (!ALIGN_EPI) { if (wr == 0) PG8_BAR; }
    PG8_BAR;
#undef PG8_SA
#undef PG8_SB
#undef PG8_STAGE
#undef PG8_STAGEB
#undef PG8_LDA
#undef PG8_LDB
#undef PG8_MMA
#undef PG8_WAIT_V
#undef PG8_WAIT_L
#undef PG8_BAR
#undef PG8_SCHED
#undef PG8_SETA
}
}

using pg8::Unit;
__device__ __forceinline__ float gelu_tanh(float x) {
    const float t = 1.5957691216057308f * (x + 0.044715f * x * x * x);
    return x * __builtin_amdgcn_rcpf(1.f + __expf(-t));
}
__device__ __forceinline__ u32x4 pack8(const f32x4 a, const f32x4 b) { u32x4 w; w.x = cvtpk(a[0], a[1]); w.y = cvtpk(a[2], a[3]); w.z = cvtpk(b[0], b[1]); w.w = cvtpk(b[2], b[3]); return w; }

struct EpiG1 {
    static constexpr bool PERM = true;
    bf16_t *AP, *Q, *KB, *VB, *SGB, *SAB; const float* rope;
    __device__ __forceinline__ void operator()(const f32x4 (&acc)[2][2][4][2], const Unit& u, int wr, int wc, int fr, int fq) const {
        const int pn = u.pn;
#pragma unroll
        for (int ai = 0; ai < 2; ++ai)
#pragma unroll
            for (int m = 0; m < 4; ++m) {
                const int row = u.pm * 256 + ai * 128 + wr * 64 + m * 16 + fr;
#pragma unroll
                for (int bj = 0; bj < 2; ++bj) {
                    const int col = pn * 256 + bj * 128 + wc * 32 + 8 * fq;
                    f32x4 v0 = acc[ai][bj][m][0], v1 = acc[ai][bj][m][1];
                    if (pn < 2) {
                        const int g = col >> 4, h0 = col & 15;
                        const int crow = row < MTOK ? (row >> 5) : (512 + ((row - MTOK) >> 5));
                        *(u32x4*)(AP + ((size_t)(g * SROWS + crow) * SK + (row & 31) * 16 + h0)) = pack8(v0, v1);
                    } else if (pn < 4 || (pn == 4 && bj == 0)) {
                        const bool isq = pn < 4;
                        const int cc = isq ? (col - 512) : (col - 1024);
                        if (row < MTOK) {
                            const int hc = cc & 63, i0 = hc >> 1;
                            const int t = row & (SEQ - 1);
                            const int pos = (i0 < 16) ? (t >> 6) : (t & 63);
                            const float* rp = rope + (pos * 16 + (i0 & 15)) * 2;
                            const f32x4 cs0 = *(const f32x4*)rp, cs1 = *(const f32x4*)(rp + 4);
                            f32x4 o0, o1;
                            o0[0] = v0[0] * cs0[0] - v0[1] * cs0[1]; o0[1] = v0[1] * cs0[0] + v0[0] * cs0[1];
                            o0[2] = v0[2] * cs0[2] - v0[3] * cs0[3]; o0[3] = v0[3] * cs0[2] + v0[2] * cs0[3];
                            o1[0] = v1[0] * cs1[0] - v1[1] * cs1[1]; o1[1] = v1[1] * cs1[0] + v1[0] * cs1[1];
                            o1[2] = v1[2] * cs1[2] - v1[3] * cs1[3]; o1[3] = v1[3] * cs1[2] + v1[2] * cs1[3];
                            v0 = o0; v1 = o1;
                        }
                        if (isq) { const float sc = 0.125f * LOG2E; v0 = v0 * sc; v1 = v1 * sc; *(u32x4*)(Q + ((size_t)row * 512 + cc)) = pack8(v0, v1); }
                        else *(u32x4*)(KB + ((size_t)row * 128 + cc)) = pack8(v0, v1);
                    } else if (pn == 4) {
                        *(u32x4*)(VB + ((size_t)row * 128 + (col - 1152))) = pack8(v0, v1);
                    } else {
#pragma unroll
                        for (int e = 0; e < 4; ++e) { v0[e] = sigmoidf_(v0[e]); v1[e] = sigmoidf_(v1[e]); }
                        if (pn < 9) *(u32x4*)(SGB + ((size_t)row * 1024 + (col - 1280))) = pack8(v0, v1);
                        else *(u32x4*)(SAB + ((size_t)row * 1024 + (col - 2304))) = pack8(v0, v1);
                    }
                }
            }
    }
};
struct EpiS5L {
    static constexpr bool PERM = false;
    float* L;
    __device__ __forceinline__ void operator()(const f32x4 (&acc)[2][2][4][2], const Unit& u, int wr, int wc, int fr, int fq) const {
#pragma unroll
        for (int ai = 0; ai < 2; ++ai)
#pragma unroll
            for (int m = 0; m < 4; ++m) {
                const int row = u.pm * 256 + ai * 128 + wr * 64 + m * 16 + fr;
                float* rp = L + ((size_t)(u.aux * SROWS + row) * 256 + wc * 32 + 4 * fq);
#pragma unroll
                for (int bj = 0; bj < 2; ++bj)
#pragma unroll
                    for (int n = 0; n < 2; ++n) *(f32x4*)(rp + bj * 128 + n * 16) = acc[ai][bj][m][n];
            }
    }
};
struct EpiS5Y {
    static constexpr bool PERM = true;
    bf16_t* Z;
    __device__ __forceinline__ void operator()(const f32x4 (&acc)[2][2][4][2], const Unit& u, int wr, int wc, int fr, int fq) const {
#pragma unroll
        for (int ai = 0; ai < 2; ++ai)
#pragma unroll
            for (int m = 0; m < 4; ++m) {
                const int crow = u.pm * 256 + ai * 128 + wr * 64 + m * 16 + fr;
#pragma unroll
                for (int bj = 0; bj < 2; ++bj) {
                    const int col = u.pn * 256 + bj * 128 + wc * 32 + 8 * fq;
                    const int tok = crow * 32 + (col >> 4);
                    f32x4 v0 = acc[ai][bj][m][0], v1 = acc[ai][bj][m][1];
#pragma unroll
                    for (int e = 0; e < 4; ++e) { v0[e] = gelu_tanh(v0[e]); v1[e] = gelu_tanh(v1[e]); }
                    *(u32x4*)(Z + ((size_t)tok * 512 + u.aux * 16 + (col & 15))) = pack8(v0, v1);
                }
            }
    }
};
struct EpiGLU {
    static constexpr bool PERM = true;
    const bf16_t* Z; bf16_t* Z2; const float* bias;
    __device__ __forceinline__ void operator()(const f32x4 (&acc)[2][2][4][2], const Unit& u, int wr, int wc, int fr, int fq) const {
#pragma unroll
        for (int bj = 0; bj < 2; ++bj) {
            const int col = u.pn * 256 + bj * 128 + wc * 32 + 8 * fq;
            const f32x4 b0 = *(const f32x4*)(bias + col), b1 = *(const f32x4*)(bias + col + 4);
#pragma unroll
            for (int ai = 0; ai < 2; ++ai)
#pragma unroll
                for (int m = 0; m < 4; ++m) {
                    const int row = u.pm * 256 + ai * 128 + wr * 64 + m * 16 + fr;
                    const u32x4 zz = *(const u32x4*)(Z + ((size_t)row * 512 + col));
                    f32x4 v0 = acc[ai][bj][m][0] + b0, v1 = acc[ai][bj][m][1] + b1;
                    v0[0] = bflo(zz.x) * sigmoidf_(v0[0]); v0[1] = bfhi(zz.x) * sigmoidf_(v0[1]); v0[2] = bflo(zz.y) * sigmoidf_(v0[2]); v0[3] = bfhi(zz.y) * sigmoidf_(v0[3]);
                    v1[0] = bflo(zz.z) * sigmoidf_(v1[0]); v1[1] = bfhi(zz.z) * sigmoidf_(v1[1]); v1[2] = bflo(zz.w) * sigmoidf_(v1[2]); v1[3] = bfhi(zz.w) * sigmoidf_(v1[3]);
                    *(u32x4*)(Z2 + ((size_t)row * 512 + col)) = pack8(v0, v1);
                }
        }
    }
};
struct EpiMerge {
    static constexpr bool PERM = false;
    const bf16_t *SGB, *SAB; float* TMP; bf16_t* MB;
    __device__ __forceinline__ void operator()(const f32x4 (&acc)[2][2][4][2], const Unit& u, int wr, int wc, int fr, int fq) const {
        const bf16_t* gsrc = u.aux ? SAB : SGB;
#pragma unroll
        for (int ai = 0; ai < 2; ++ai)
#pragma unroll
            for (int m = 0; m < 4; ++m) {
                const int row = u.pm * 256 + ai * 128 + wr * 64 + m * 16 + fr;
#pragma unroll
                for (int bj = 0; bj < 2; ++bj)
#pragma unroll
                    for (int n = 0; n < 2; ++n) {
                        const size_t off = (size_t)row * 1024 + u.pn * 256 + bj * 128 + wc * 32 + n * 16 + 4 * fq;
                        const u32x2 gg = *(const u32x2*)(gsrc + off);
                        f32x4 v = acc[ai][bj][m][n];
                        v[0] *= bflo(gg.x); v[1] *= bfhi(gg.x); v[2] *= bflo(gg.y); v[3] *= bfhi(gg.y);
                        if (u.aux == 0) *(f32x4*)(TMP + off) = v;
                        else { v = v + *(const f32x4*)(TMP + off); u32x2 w; w.x = cvtpk(v[0], v[1]); w.y = cvtpk(v[2], v[3]); *(u32x2*)(MB + off) = w; }
                    }
            }
    }
};
struct EpiWO {
    static constexpr bool PERM = false;
    const float *x, *st0, *lg, *lb, *mod; float* R1;
    __device__ __forceinline__ void operator()(const f32x4 (&acc)[2][2][4][2], const Unit& u, int wr, int wc, int fr, int fq) const {
        const int b = u.pm >> 4;
        const float* g1 = mod + b * 6144 + 2 * 1024;
#pragma unroll
        for (int bj = 0; bj < 2; ++bj)
#pragma unroll
            for (int n = 0; n < 2; ++n) {
                const int col = u.pn * 256 + bj * 128 + wc * 32 + n * 16 + 4 * fq;
                const f32x4 gv = *(const f32x4*)(g1 + col), lgv = *(const f32x4*)(lg + col), lbv = *(const f32x4*)(lb + col);
#pragma unroll
                for (int ai = 0; ai < 2; ++ai)
#pragma unroll
                    for (int m = 0; m < 4; ++m) {
                        const int row = u.pm * 256 + ai * 128 + wr * 64 + m * 16 + fr;
                        const f32x2 st = *(const f32x2*)(st0 + row * 2);
                        const f32x4 xv = *(const f32x4*)(x + (size_t)row * 1024 + col);
                        const f32x4 h = (xv - st.x) * st.y * lgv + lbv;
                        *(f32x4*)(R1 + (size_t)row * 1024 + col) = h * DN_ALPHA + gv * acc[ai][bj][m][n];
                    }
            }
    }
};
struct MoeTab { volatile LAS int* t; };
struct EpiMoe1 {
    static constexpr bool PERM = true;
    bf16_t* H; const float* bgu;
    __device__ __forceinline__ void operator()(const f32x4 (&acc)[2][2][4][2], const Unit& u, int wr, int wc, int fr, int fq) const {
        const int f0 = u.pn * 128 + wc * 32 + 8 * fq;
        const float* bp = bgu + (size_t)u.aux * 2048 + f0;
        const f32x4 bg0 = *(const f32x4*)bp, bg1 = *(const f32x4*)(bp + 4), bl0 = *(const f32x4*)(bp + 1024), bl1 = *(const f32x4*)(bp + 1028);
#pragma unroll
        for (int ai = 0; ai < 2; ++ai)
#pragma unroll
            for (int m = 0; m < 4; ++m) {
                const int row = u.pm * 256 + ai * 128 + wr * 64 + m * 16 + fr;
                f32x4 g0 = acc[ai][0][m][0] + bg0, g1 = acc[ai][0][m][1] + bg1, l0 = acc[ai][1][m][0] + bl0, l1 = acc[ai][1][m][1] + bl1;
#pragma unroll
                for (int e = 0; e < 4; ++e) {
                    float ga = fminf(g0[e], 7.f), la = fminf(fmaxf(l0[e], -7.f), 7.f); g0[e] = ga * sigmoidf_(1.702f * ga) * (la + 1.f);
                    ga = fminf(g1[e], 7.f); la = fminf(fmaxf(l1[e], -7.f), 7.f); g1[e] = ga * sigmoidf_(1.702f * ga) * (la + 1.f);
                }
                *(u32x4*)(H + ((size_t)row * 1024 + f0)) = pack8(g0, g1);
            }
    }
};
struct EpiMoe2 {
    static constexpr bool PERM = true;
    bf16_t* YR; const float* bd; const float* lgate; MoeTab tab;
    __device__ __forceinline__ void operator()(const f32x4 (&acc)[2][2][4][2], const Unit& u, int wr, int wc, int fr, int fq) const {
        const int e = u.aux, rt = u.pm - tab.t[e], cnt = tab.t[64 + e];
#pragma unroll
        for (int bj = 0; bj < 2; ++bj) {
            const int col = u.pn * 256 + bj * 128 + wc * 32 + 8 * fq;
            const f32x4 b0 = *(const f32x4*)(bd + (size_t)e * 1024 + col), b1 = *(const f32x4*)(bd + (size_t)e * 1024 + col + 4);
#pragma unroll
            for (int ai = 0; ai < 2; ++ai)
#pragma unroll
                for (int m = 0; m < 4; ++m) {
                    const int lr = ai * 128 + wr * 64 + m * 16 + fr, idx = rt * 256 + lr;
                    const float gt = idx < cnt ? lgate[(size_t)e * LCAP + idx] : 0.f;
                    const f32x4 v0 = (acc[ai][bj][m][0] + b0) * gt, v1 = (acc[ai][bj][m][1] + b1) * gt;
                    *(u32x4*)(YR + ((size_t)(u.pm * 256 + lr) * 1024 + col)) = pack8(v0, v1);
                }
        }
    }
};

struct SchedG1 {
    static constexpr bool GATHER = false;
    const char *A, *Bt; int G, vcu;
    __device__ __forceinline__ bool next(int i, Unit& u) const {
        const int L = i * G + vcu; if (L >= 844) return false;
        int pm, pn;
        if (L < 832) { const int grp = L / 104, w = L % 104; pm = grp * 8 + (w & 7); pn = w >> 3; }
        else { const int j = L - 832; pm = 64 + (j & 3); const int c = j >> 2; pn = c == 2 ? 4 : c; }
        u.pm = pm; u.pn = pn; u.aux = 0; u.a = A + (size_t)pm * 256 * 2048; u.b = Bt + (size_t)pn * 256 * 2048; return true;
    }
    __device__ __forceinline__ unsigned arow(const Unit&, int R) const { return (unsigned)R; }
};
struct SchedS5L {
    static constexpr bool GATHER = false;
    const char *AP, *BTL; int G, vcu;
    __device__ __forceinline__ bool next(int i, Unit& u) const {
        const int L = i * G + vcu; if (L >= 96) return false;
        const int g = L / 3, pm = L % 3;
        u.pm = pm; u.pn = 0; u.aux = g; u.a = AP + ((size_t)(g * SROWS + pm * 256) * SK) * 2; u.b = BTL + (size_t)g * 256 * 512 * 2; return true;
    }
    __device__ __forceinline__ unsigned arow(const Unit&, int R) const { return (unsigned)R; }
};
struct SchedS5Y {
    static constexpr bool GATHER = false;
    const char *AP, *BTY; int G, vcu;
    __device__ __forceinline__ bool next(int i, Unit& u) const {
        const int L = i * G + vcu; if (L >= 128) return false;
        const int g = L >> 2, pm = (L >> 1) & 1, pn = L & 1;
        u.pm = pm; u.pn = pn; u.aux = g; u.a = AP + ((size_t)(g * SROWS + pm * 256) * SK) * 2; u.b = BTY + ((size_t)(g * 512 + pn * 256) * SK) * 2; return true;
    }
    __device__ __forceinline__ unsigned arow(const Unit&, int R) const { return (unsigned)R; }
};
struct SchedPlain {
    static constexpr bool GATHER = false;
    const char *A, *Bt; int nM, nN, K, G, vcu;
    __device__ __forceinline__ bool next(int i, Unit& u) const {
        const int L = i * G + vcu; if (L >= nM * nN) return false;
        const int nig = 8 * nN, grp = L / nig, w = L % nig;
        u.pm = grp * 8 + (w & 7); u.pn = w >> 3; u.aux = 0;
        u.a = A + (size_t)u.pm * 256 * K * 2; u.b = Bt + (size_t)u.pn * 256 * K * 2; return true;
    }
    __device__ __forceinline__ unsigned arow(const Unit&, int R) const { return (unsigned)R; }
};
struct SchedMerge {
    static constexpr bool GATHER = false;
    const char *Z2, *OA, *WSO, *WAO; int G, vcu;
    __device__ __forceinline__ bool next(int i, Unit& u) const {
        const int tile = (i >> 1) * G + vcu; if (tile >= 256) return false;
        const int part = i & 1, grp = tile >> 5, w = tile & 31;
        u.pm = grp * 8 + (w & 7); u.pn = w >> 3; u.aux = part;
        u.a = (part ? OA : Z2) + (size_t)u.pm * 256 * 512 * 2; u.b = (part ? WAO : WSO) + (size_t)u.pn * 256 * 512 * 2; return true;
    }
    __device__ __forceinline__ unsigned arow(const Unit&, int R) const { return (unsigned)R; }
};
template <int NPN, bool GATH>
struct SchedMoe {
    static constexpr bool GATHER = GATH;
    const char *A, *Bt; const int* list; MoeTab tab; int G, vcu;
    __device__ __forceinline__ bool next(int i, Unit& u) const {
        const int L = i * G + vcu; const int total = tab.t[32] * NPN; if (L >= total) return false;
        int e = 0;
        while (e < 31 && tab.t[e + 1] * NPN <= L) ++e;
        const int tb = tab.t[e], nt = tab.t[e + 1] - tb, w = L - tb * NPN;
        const int pn = w / nt, rt = w % nt;
        u.pm = tb + rt; u.pn = pn; u.aux = e;
        if (GATH) { u.a = A; u.b = Bt + ((size_t)e * 2048 + pn * 256) * 2048; }
        else { u.a = A + (size_t)u.pm * 256 * 2048; u.b = Bt + ((size_t)e * 1024 + pn * 256) * 2048; }
        return true;
    }
    __device__ __forceinline__ unsigned arow(const Unit& u, int R) const {
        const int e = u.aux, idx = (u.pm - tab.t[e]) * 256 + R;
        return idx < tab.t[64 + e] ? (unsigned)list[(size_t)e * LCAP + idx] : 0u;
    }
};

struct Args { const void* in[33]; float* out; unsigned char* ws; int ph_lo, ph_hi; };
struct Frame {
    LAS unsigned char* lds; volatile LAS int* MISC;
    int tid, lane, wave, vcu, G;
    unsigned char* ws; const Args* a;
};
#define IN_F(k) ((const float*)args.in[k])
enum { I_X = 0, I_C, I_CTX, I_CCTX, I_LNG, I_LNB, I_WMOD, I_BMOD, I_WIN, I_LRE, I_LIM, I_LSTEP, I_BRE, I_BIM, I_CRE, I_CIM, I_SD, I_WGLU, I_BGLU, I_SINK, I_WSO, I_WAO, I_WO,
       I_LN1G, I_LN1B, I_WR, I_BR, I_WGU, I_BGU, I_WD, I_BD, I_LN2G, I_LN2B };

template <int MAP> __device__ __forceinline__ int dest_row(int n) {
    if (MAP == 1) { return (n >= 512 && n < 1152) ? ((n & ~63) + 2 * (n & 31) + ((n >> 5) & 1)) : n; }
    if (MAP == 2) { const int f = n & 1023, lin = n >> 10; return (f >> 7) * 256 + lin * 128 + (f & 127); }
    return n;
}
template <int MAP> __device__ __forceinline__ void transpose_item(const float* W, int K, int N, bf16_t* WT, LAS float* scr, int item, int lane) {
    const int nblk = N / 32, kb = item / nblk, nb = item % nblk, k0 = 64 * kb, n0 = 32 * nb;
#pragma unroll 8
    for (int i = 0; i < 32; ++i) { const int kk = 2 * i + (lane >> 5); scr[kk * 33 + (lane & 31)] = W[(size_t)(k0 + kk) * N + n0 + (lane & 31)]; }
    LDS_WAIT(); asm volatile("" ::: "memory");
    const int c = lane & 7;
#pragma unroll
    for (int j = 0; j < 4; ++j) { const int n = (lane >> 3) + 8 * j; const LAS float* s = scr + (8 * c) * 33 + n;
        u32x4 o; o.x = cvtpk(s[0 * 33], s[1 * 33]); o.y = cvtpk(s[2 * 33], s[3 * 33]); o.z = cvtpk(s[4 * 33], s[5 * 33]); o.w = cvtpk(s[6 * 33], s[7 * 33]);
        *(u32x4*)(WT + (size_t)dest_row<MAP>(n0 + n) * K + k0 + 8 * c) = o; }
    LDS_WAIT(); asm volatile("" ::: "memory");
}
struct Cx { float re, im; };
__device__ __forceinline__ Cx cmul(Cx a, Cx b) { return Cx{a.re * b.re - a.im * b.im, a.re * b.im + a.im * b.re}; }
__device__ __forceinline__ Cx apow(float lr, float li, float dt, float n) {
    const float mag = expf(lr * dt * n); const float ang = li * dt * n;
    const float k = rintf(ang * 0.15915494309189535f); float r = fmaf(-k, 6.2831854820251465f, ang); r = fmaf(-k, -1.7484555e-7f, r);
    float s, c; sincosf(r, &s, &c); return Cx{mag * c, mag * s};
}
__device__ __forceinline__ Cx s5coef(float lr, float li, float dt) {
    const Cx a = apow(lr, li, dt, 1.f); const float den = lr * lr + li * li; const float ar1 = a.re - 1.f;
    return Cx{(ar1 * lr + a.im * li) / den, (a.im * lr - ar1 * li) / den};
}

__device__ __forceinline__ void p0_prep(const Args& args, Frame& F) {
    unsigned char* ws = F.ws;
    {
        LAS float* sc = (LAS float*)F.lds; LAS float* red = sc + 5 * 1024;
        const float* c = IN_F(I_C); const float* cc = IN_F(I_CCTX); const float* wm = IN_F(I_WMOD); const float* bm = IN_F(I_BMOD); float* mod = (float*)(ws + WS_MOD);
        if (F.vcu < 96) {
            for (int idx = F.tid; idx < 5 * 1024; idx += NTHR) { const int j = idx >> 10, k = idx & 1023; const float v = j < 4 ? c[j * 1024 + k] : cc[k]; sc[idx] = v * sigmoidf_(v); }
            __syncthreads();
            for (int slab = F.vcu; slab < 96; slab += F.G) {
                const int kq = F.tid >> 6, cl = F.tid & 63, col = slab * 64 + cl;
                float acc[5] = {0.f, 0.f, 0.f, 0.f, 0.f};
#pragma unroll 8
                for (int k = kq * 128; k < kq * 128 + 128; ++k) { const float w = wm[(size_t)k * 6144 + col];
#pragma unroll
                    for (int j = 0; j < 5; ++j) acc[j] += sc[j * 1024 + k] * w; }
#pragma unroll
                for (int j = 0; j < 5; ++j) red[(kq * 5 + j) * 64 + cl] = acc[j];
                __syncthreads();
                if (F.tid < 320) { const int j = F.tid >> 6; float s = 0.f;
#pragma unroll
                    for (int q = 0; q < 8; ++q) s += red[(q * 5 + j) * 64 + cl];
                    mod[j * 6144 + col] = s + bm[col]; }
                __syncthreads();
            }
        }
        const int gt = F.vcu * NTHR + F.tid;
        if (gt < 1024) { const int pos = gt >> 4, fi = gt & 15; const float inv = exp2f(-(float)fi * (13.287712379549449f / 16.f)); const float ang = (float)pos * inv;
            float s, cs; sincosf(ang, &s, &cs); float* rp = (float*)(ws + WS_ROPE); rp[gt * 2] = cs; rp[gt * 2 + 1] = s; }
    }
    __syncthreads();
    const int gw = F.vcu * NWAVES + F.wave, NGW = F.G * NWAVES;
    {
        const float* lre = IN_F(I_LRE); const float* lim = IN_F(I_LIM); const float* lst = IN_F(I_LSTEP);
        const float* bre = IN_F(I_BRE); const float* bim = IN_F(I_BIM); const float* cre = IN_F(I_CRE); const float* cim = IN_F(I_CIM); const float* sd = IN_F(I_SD);
        bf16_t* BTY = (bf16_t*)(ws + WS_BTY); bf16_t* BTL = (bf16_t*)(ws + WS_BTL);
        LAS float* wl = (LAS float*)F.lds + F.wave * 256;
        const int p = F.lane;
        constexpr int NT_ITEMS = 32 * 63, NE_ITEMS = 32 * 32, NF_ITEMS = 32 * 32;
        for (int it = gw; it < NT_ITEMS + NE_ITEMS + NF_ITEMS; it += NGW) {
            if (it < NT_ITEMS) {
                const int g = it / 63, ds = it % 63 - 31, d = ds < 0 ? -ds : ds;
#pragma unroll
                for (int dir = 0; dir < 2; ++dir) {
                    const float lr = lre[(dir * 32 + g) * 64 + p], li = lim[(dir * 32 + g) * 64 + p], dt = expf(lst[dir * 32 + g]);
                    const Cx w = cmul(apow(lr, li, dt, (float)d), s5coef(lr, li, dt));
                    wl[(dir * 64 + p) * 2] = w.re; wl[(dir * 64 + p) * 2 + 1] = w.im;
                }
                LDS_WAIT(); asm volatile("" ::: "memory");
                const int h = F.lane >> 2, hp0 = (F.lane & 3) * 4;
                float kv[4] = {0.f, 0.f, 0.f, 0.f};
#pragma unroll
                for (int dir = 0; dir < 2; ++dir) {
                    if ((dir == 0 && ds < 0) || (dir == 1 && ds > 0)) continue;
                    const float* cr = cre + ((size_t)(dir * 32 + g) * 16 + h) * 64; const float* ci = cim + ((size_t)(dir * 32 + g) * 16 + h) * 64;
                    const float* br = bre + (size_t)(dir * 32 + g) * 64 * 16 + hp0; const float* bi = bim + (size_t)(dir * 32 + g) * 64 * 16 + hp0;
                    for (int q = 0; q < 64; ++q) {
                        const float wr_ = wl[(dir * 64 + q) * 2], wi_ = wl[(dir * 64 + q) * 2 + 1];
                        const float c_r = cr[q], c_i = ci[q]; const float xr = c_r * wr_ - c_i * wi_, xi = c_r * wi_ + c_i * wr_;
                        const f32x4 b_r = *(const f32x4*)(br + q * 16), b_i = *(const f32x4*)(bi + q * 16);
#pragma unroll
                        for (int e = 0; e < 4; ++e) kv[e] += xr * b_r[e] - xi * b_i[e];
                    }
                }
                if (ds == 0) {
#pragma unroll
                    for (int e = 0; e < 4; ++e) if (hp0 + e == h) kv[e] += sd[g * 16 + h]; }
                u32x2 w2; w2.x = cvtpk(kv[0], kv[1]); w2.y = cvtpk(kv[2], kv[3]);
                for (int i = (ds > 0 ? d : 0); i < (ds < 0 ? 32 - d : 32); ++i) { const int j = i - ds;
                    *(u32x2*)(BTY + ((size_t)(g * 512 + i * 16 + h) * SK + j * 16 + hp0)) = w2; }
                LDS_WAIT(); asm volatile("" ::: "memory");
            } else if (it < NT_ITEMS + NE_ITEMS) {
                const int e2 = it - NT_ITEMS, g = e2 >> 5, i = e2 & 31;
#pragma unroll
                for (int dir = 0; dir < 2; ++dir) {
                    const float lr = lre[(dir * 32 + g) * 64 + p], li = lim[(dir * 32 + g) * 64 + p], dt = expf(lst[dir * 32 + g]);
                    const Cx a = apow(lr, li, dt, dir == 0 ? (float)(i + 1) : (float)(32 - i));
                    for (int h = 0; h < 16; ++h) {
                        const Cx cc = Cx{cre[((size_t)(dir * 32 + g) * 16 + h) * 64 + p], cim[((size_t)(dir * 32 + g) * 16 + h) * 64 + p]};
                        const Cx ev = cmul(cc, a);
                        bf16_t* rowp = BTY + (size_t)(g * 512 + i * 16 + h) * SK + 512 + dir * 128 + p;
                        rowp[0] = (bf16_t)(cvtpk(ev.re, 0.f) & 0xffffu); rowp[64] = (bf16_t)(cvtpk(-ev.im, 0.f) & 0xffffu);
                    }
                }
            } else {
                const int f2 = it - NT_ITEMS - NE_ITEMS, g = f2 >> 5, j = f2 & 31;
#pragma unroll
                for (int dir = 0; dir < 2; ++dir) {
                    const float lr = lre[(dir * 32 + g) * 64 + p], li = lim[(dir * 32 + g) * 64 + p], dt = expf(lst[dir * 32 + g]);
                    const Cx w = cmul(apow(lr, li, dt, dir == 0 ? (float)(31 - j) : (float)j), s5coef(lr, li, dt));
                    const float* br = bre + ((size_t)(dir * 32 + g) * 64 + p) * 16; const float* bi = bim + ((size_t)(dir * 32 + g) * 64 + p) * 16;
                    float fr_[16], fi_[16];
#pragma unroll
                    for (int q4 = 0; q4 < 4; ++q4) { const f32x4 b_r = *(const f32x4*)(br + q4 * 4), b_i = *(const f32x4*)(bi + q4 * 4);
#pragma unroll
                        for (int e = 0; e < 4; ++e) { fr_[q4 * 4 + e] = w.re * b_r[e] - w.im * b_i[e]; fi_[q4 * 4 + e] = w.re * b_i[e] + w.im * b_r[e]; } }
                    bf16_t* r0 = BTL + ((size_t)(g * 256 + dir * 128 + p) * 512 + j * 16); bf16_t* r1 = r0 + (size_t)64 * 512;
                    u32x4 o;
                    o.x = cvtpk(fr_[0], fr_[1]); o.y = cvtpk(fr_[2], fr_[3]); o.z = cvtpk(fr_[4], fr_[5]); o.w = cvtpk(fr_[6], fr_[7]); *(u32x4*)r0 = o;
                    o.x = cvtpk(fr_[8], fr_[9]); o.y = cvtpk(fr_[10], fr_[11]); o.z = cvtpk(fr_[12], fr_[13]); o.w = cvtpk(fr_[14], fr_[15]); *(u32x4*)(r0 + 8) = o;
                    o.x = cvtpk(fi_[0], fi_[1]); o.y = cvtpk(fi_[2], fi_[3]); o.z = cvtpk(fi_[4], fi_[5]); o.w = cvtpk(fi_[6], fi_[7]); *(u32x4*)r1 = o;
                    o.x = cvtpk(fi_[8], fi_[9]); o.y = cvtpk(fi_[10], fi_[11]); o.z = cvtpk(fi_[12], fi_[13]); o.w = cvtpk(fi_[14], fi_[15]); *(u32x4*)(r1 + 8) = o;
                }
            }
        }
    }
    __syncthreads();
    {
        LAS float* scr = (LAS float*)(F.lds + F.wave * 16384);
        constexpr int I0 = 16 * 104, I1 = 8 * 16, I2 = 8 * 32, I3 = 8 * 32, I4 = 16 * 32, I5 = 32 * 16 * 64, I6 = 32 * 16 * 32;
        constexpr int NITEMS = I0 + I1 + I2 + I3 + I4 + I5 + I6;
        for (int it = gw; it < NITEMS; it += NGW) {
            int r = it;
            if (r < I5) { const int e = r >> 10; transpose_item<2>(IN_F(I_WGU) + (size_t)e * 1024 * 2048, 1024, 2048, (bf16_t*)(ws + WS_WGUT) + (size_t)e * 2048 * 1024, scr, r & 1023, F.lane); continue; } r -= I5;
            if (r < I6) { const int e = r >> 9; transpose_item<0>(IN_F(I_WD) + (size_t)e * 1024 * 1024, 1024, 1024, (bf16_t*)(ws + WS_WDT) + (size_t)e * 1024 * 1024, scr, r & 511, F.lane); continue; } r -= I6;
            if (r < I0) { transpose_item<1>(IN_F(I_WIN), 1024, INC, (bf16_t*)(ws + WS_WINT), scr, r, F.lane); continue; } r -= I0;
            if (r < I1) { transpose_item<0>(IN_F(I_WGLU), 512, 512, (bf16_t*)(ws + WS_WGLUT), scr, r, F.lane); continue; } r -= I1;
            if (r < I2) { transpose_item<0>(IN_F(I_WSO), 512, 1024, (bf16_t*)(ws + WS_WSOT), scr, r, F.lane); continue; } r -= I2;
            if (r < I3) { transpose_item<0>(IN_F(I_WAO), 512, 1024, (bf16_t*)(ws + WS_WAOT), scr, r, F.lane); continue; } r -= I3;
            transpose_item<0>(IN_F(I_WO), 1024, 1024, (bf16_t*)(ws + WS_WOT), scr, r, F.lane);
        }
    }
}

__device__ __forceinline__ void p1_lnmod(const Args& args, Frame& F) {
    const float* lg = IN_F(I_LNG); const float* lb = IN_F(I_LNB); const float* mod = (const float*)(F.ws + WS_MOD);
    float* st0 = (float*)(F.ws + WS_ST0); bf16_t* U = (bf16_t*)(F.ws + WS_U);
    const int gw = F.vcu * NWAVES + F.wave, NGW = F.G * NWAVES;
    for (int r = gw; r < MALL; r += NGW) {
        const float* src = r < MTOK ? IN_F(I_X) + (size_t)r * D : IN_F(I_CTX) + (size_t)(r - MTOK) * D;
        const int mj = r < MTOK ? (r >> 12) : 4;
        const f32x4* xr = (const f32x4*)src + F.lane;
        f32x4 v[4]; float s = 0.f;
#pragma unroll
        for (int j = 0; j < 4; ++j) { v[j] = xr[64 * j]; s += (v[j][0] + v[j][1]) + (v[j][2] + v[j][3]); }
        const float mean = wave_sum(s) * (1.f / D); float s2 = 0.f;
#pragma unroll
        for (int j = 0; j < 4; ++j) { v[j] = v[j] - mean; s2 += (v[j][0] * v[j][0] + v[j][1] * v[j][1]) + (v[j][2] * v[j][2] + v[j][3] * v[j][3]); }
        const float rstd = 1.f / sqrtf(wave_sum(s2) * (1.f / D) + LN_EPS);
        if (F.lane == 0) { st0[r * 2] = mean; st0[r * 2 + 1] = rstd; }
        const f32x4* sh = (const f32x4*)(mod + mj * 6144) + F.lane; const f32x4* sc = (const f32x4*)(mod + mj * 6144 + 1024) + F.lane;
        const f32x4* g4 = (const f32x4*)lg + F.lane; const f32x4* b4 = (const f32x4*)lb + F.lane;
        u32x2* o8 = (u32x2*)(U + (size_t)r * D) + F.lane;
#pragma unroll
        for (int j = 0; j < 4; ++j) { const f32x4 h = v[j] * rstd * g4[64 * j] + b4[64 * j]; const f32x4 u = h * (sc[64 * j] + 1.f) + sh[64 * j];
            u32x2 w; w.x = cvtpk(u[0], u[1]); w.y = cvtpk(u[2], u[3]); o8[64 * j] = w; }
    }
}

__device__ __forceinline__ int crow16(int r, int hi) { return (r & 3) + 8 * (r >> 2) + 4 * hi; }
__device__ __forceinline__ void attn_phase(const Args& args, Frame& F) {
    const bf16_t* Q = (const bf16_t*)(F.ws + WS_Q); const bf16_t* KB = (const bf16_t*)(F.ws + WS_KB); const bf16_t* VB = (const bf16_t*)(F.ws + WS_VB);
    bf16_t* OA = (bf16_t*)(F.ws + WS_OATT); const float* sink = IN_F(I_SINK);
    LAS unsigned char* Ks = F.lds; LAS unsigned char* Vt = F.lds + 9216; LAS float* wsf = (LAS float*)(F.lds + 17920) + F.wave * 64;
    const int lane = F.lane, r = lane & 31, hi = lane >> 5, wave = F.wave, tid = F.tid;
    const int key = tid >> 3, ch = tid & 7;
    for (int unit = F.vcu; unit < 256; unit += F.G) {
        const int nb = unit & 31, kvh = (unit >> 5) & 1, b = unit >> 6;
        const int q0 = nb * 128, head = kvh * 4 + (wave >> 1), qs = q0 + (wave & 1) * 64;
        bf16x8 qf[2][4];
#pragma unroll
        for (int g2 = 0; g2 < 2; ++g2)
#pragma unroll
            for (int s = 0; s < 4; ++s) qf[g2][s] = *(const bf16x8*)(Q + ((size_t)(b * SEQ + qs + g2 * 32 + r) * 512 + head * 64 + s * 16 + hi * 8));
        float mrun[2], lrun[2]; f32x16 o[2][2];
#pragma unroll
        for (int g2 = 0; g2 < 2; ++g2) { mrun[g2] = sink[head] * LOG2E; lrun[g2] = hi == 0 ? 1.f : 0.f; o[g2][0] = f32x16{}; o[g2][1] = f32x16{}; }
        int tt = 0;
        u32x4 kreg, vreg;
        { const size_t row = (size_t)(MTOK + b * CTX + key); kreg = *(const u32x4*)(KB + row * 128 + kvh * 64 + ch * 8); vreg = *(const u32x4*)(VB + row * 128 + kvh * 64 + ch * 8); }
        while (tt < 10) {
            __syncthreads();
            *(LAS u32x4*)(Ks + key * 144 + ch * 16) = kreg;
            { LAS unsigned short* vp = (LAS unsigned short*)(Vt + (ch * 8) * 136 + key * 2);
              vp[0 * 68] = (unsigned short)(vreg.x & 0xffffu); vp[1 * 68] = (unsigned short)(vreg.x >> 16); vp[2 * 68] = (unsigned short)(vreg.y & 0xffffu); vp[3 * 68] = (unsigned short)(vreg.y >> 16);
              vp[4 * 68] = (unsigned short)(vreg.z & 0xffffu); vp[5 * 68] = (unsigned short)(vreg.z >> 16); vp[6 * 68] = (unsigned short)(vreg.w & 0xffffu); vp[7 * 68] = (unsigned short)(vreg.w >> 16); }
            __syncthreads();
            const int cur = tt; const bool masked = cur >= 4; const int j0 = q0 - 128 + (cur - 4) * 64;
            int nx = cur + 1;
            while (nx < 10) { const int jn = q0 - 128 + (nx - 4) * 64; if (nx < 4 || (jn >= 0 && jn < SEQ)) break; ++nx; }
            if (nx < 10) { const size_t row = nx < 4 ? (size_t)(MTOK + b * CTX + nx * 64 + key) : (size_t)(b * SEQ + q0 - 128 + (nx - 4) * 64 + key);
                kreg = *(const u32x4*)(KB + row * 128 + kvh * 64 + ch * 8); vreg = *(const u32x4*)(VB + row * 128 + kvh * 64 + ch * 8); }
            tt = nx;
#pragma unroll
            for (int g2 = 0; g2 < 2; ++g2) {
                f32x16 p0 = f32x16{}, p1 = f32x16{};
#pragma unroll
                for (int s = 0; s < 4; ++s) {
                    const bf16x8 kf0 = *(const LAS bf16x8*)(Ks + r * 144 + (s * 16 + hi * 8) * 2), kf1 = *(const LAS bf16x8*)(Ks + (32 + r) * 144 + (s * 16 + hi * 8) * 2);
                    p0 = __builtin_amdgcn_mfma_f32_32x32x16_bf16(kf0, qf[g2][s], p0, 0, 0, 0); p1 = __builtin_amdgcn_mfma_f32_32x32x16_bf16(kf1, qf[g2][s], p1, 0, 0, 0);
                }
                if (masked) { const int qpos = qs + g2 * 32 + r;
#pragma unroll
                    for (int e = 0; e < 16; ++e) { const int d0 = j0 + crow16(e, hi) - qpos; if (d0 > 128 || d0 < -128) p0[e] = -1e30f; const int d1 = d0 + 32; if (d1 > 128 || d1 < -128) p1[e] = -1e30f; } }
                float tm = fmaxf(p0[0], p1[0]);
#pragma unroll
                for (int e = 1; e < 16; ++e) tm = fmaxf(tm, fmaxf(p0[e], p1[e]));
                tm = fmaxf(tm, __shfl_xor(tm, 32));
                const float mn = fmaxf(mrun[g2], tm); const float alpha = __builtin_amdgcn_exp2f(mrun[g2] - mn); mrun[g2] = mn;
                float rs = 0.f;
#pragma unroll
                for (int e = 0; e < 16; ++e) { p0[e] = __builtin_amdgcn_exp2f(p0[e] - mn); p1[e] = __builtin_amdgcn_exp2f(p1[e] - mn); rs += p0[e] + p1[e]; }
                lrun[g2] = lrun[g2] * alpha + rs;
                if (hi == 0) wsf[g2 * 32 + r] = alpha;
#pragma unroll
                for (int e = 0; e < 16; ++e) { const float a = wsf[g2 * 32 + crow16(e, hi)]; o[g2][0][e] *= a; o[g2][1][e] *= a; }
                u32x4 pw[4];
#pragma unroll
                for (int q4 = 0; q4 < 4; ++q4) { pw[0][q4] = cvtpk(p0[2 * q4], p0[2 * q4 + 1]); pw[1][q4] = cvtpk(p0[8 + 2 * q4], p0[8 + 2 * q4 + 1]); pw[2][q4] = cvtpk(p1[2 * q4], p1[2 * q4 + 1]); pw[3][q4] = cvtpk(p1[8 + 2 * q4], p1[8 + 2 * q4 + 1]); }
#pragma unroll
                for (int dh = 0; dh < 2; ++dh)
#pragma unroll
                    for (int s = 0; s < 4; ++s) { const int kb = 16 * (s & 1) + 32 * (s >> 1);
                        const u32x2 lo = *(const LAS u32x2*)(Vt + (dh * 32 + r) * 136 + (kb + 4 * hi) * 2), h2 = *(const LAS u32x2*)(Vt + (dh * 32 + r) * 136 + (kb + 8 + 4 * hi) * 2);
                        const u32x4 vv = {lo.x, lo.y, h2.x, h2.y};
                        o[g2][dh] = __builtin_amdgcn_mfma_f32_32x32x16_bf16(__builtin_bit_cast(bf16x8, pw[s]), __builtin_bit_cast(bf16x8, vv), o[g2][dh], 0, 0, 0); }
            }
        }
#pragma unroll
        for (int g2 = 0; g2 < 2; ++g2) {
            const float lt = lrun[g2] + __shfl_xor(lrun[g2], 32);
            if (hi == 0) wsf[g2 * 32 + r] = 1.f / lt;
#pragma unroll
            for (int e = 0; e < 16; ++e) { const float a = wsf[g2 * 32 + crow16(e, hi)];
                bf16_t* op = OA + ((size_t)(b * SEQ + qs + g2 * 32 + crow16(e, hi)) * 512 + head * 64 + r);
                op[0] = (bf16_t)(cvtpk(o[g2][0][e] * a, 0.f) & 0xffffu); op[32] = (bf16_t)(cvtpk(o[g2][1][e] * a, 0.f) & 0xffffu); }
        }
    }
    __syncthreads();
}

__device__ __forceinline__ void scan_phase(const Args& args, Frame& F) {
    if (F.tid >= 64) return;
    const int gt = F.vcu * 64 + F.tid; if (gt >= NB * SG * 128) return;
    const int q = gt & 127, dir = q >> 6, p = q & 63, g = (gt >> 7) & 31, b = gt >> 12;
    const float* L = (const float*)(F.ws + WS_LBUF) + (size_t)g * SROWS * 256 + dir * 128 + p;
    bf16_t* AP = (bf16_t*)(F.ws + WS_AP) + (size_t)g * SROWS * SK + 512 + dir * 128 + p;
    const float lr = IN_F(I_LRE)[(dir * 32 + g) * 64 + p], li = IN_F(I_LIM)[(dir * 32 + g) * 64 + p], dt = expf(IN_F(I_LSTEP)[dir * 32 + g]);
    const Cx a32 = apow(lr, li, dt, 32.f);
    Cx S = Cx{0.f, 0.f};
    if (dir == 0) {
        for (int cc = 0; cc < 8; ++cc) { const float* lp = L + (size_t)(512 + b * 8 + cc) * 256; const Cx t = cmul(a32, S); S = Cx{t.re + lp[0], t.im + lp[64]}; }
        for (int c = 0; c < 128; ++c) { const int row = b * 128 + c; bf16_t* ap = AP + (size_t)row * SK; ap[0] = (bf16_t)(cvtpk(S.re, 0.f) & 0xffffu); ap[64] = (bf16_t)(cvtpk(S.im, 0.f) & 0xffffu);
            const float* lp = L + (size_t)row * 256; const Cx t = cmul(a32, S); S = Cx{t.re + lp[0], t.im + lp[64]}; }
    } else {
        for (int cc = 7; cc >= 0; --cc) { const float* lp = L + (size_t)(512 + b * 8 + cc) * 256; const Cx t = cmul(a32, S); S = Cx{t.re + lp[0], t.im + lp[64]}; }
        for (int c = 127; c >= 0; --c) { const int row = b * 128 + c; bf16_t* ap = AP + (size_t)row * SK; ap[0] = (bf16_t)(cvtpk(S.re, 0.f) & 0xffffu); ap[64] = (bf16_t)(cvtpk(S.im, 0.f) & 0xffffu);
            const float* lp = L + (size_t)row * 256; const Cx t = cmul(a32, S); S = Cx{t.re + lp[0], t.im + lp[64]}; }
    }
}

__device__ __forceinline__ void router_phase(const Args& args, Frame& F) {
    unsigned char* ws = F.ws;
    LAS float* wT = (LAS float*)F.lds;
    volatile LAS int* cnt = F.MISC + 128; volatile LAS int* base = F.MISC + 160; volatile LAS int* rinfo = F.MISC + 256;
    LAS float* rgate = (LAS float*)(F.MISC + 512);
    const float* wr = IN_F(I_WR);
    for (int idx = F.tid; idx < 32 * 1024; idx += NTHR) { const int k = idx >> 5, e = idx & 31; wT[e * 1024 + k] = wr[idx]; }
    if (F.tid < 32) cnt[F.tid] = 0;
    __syncthreads();
    const float* R1 = (const float*)(ws + WS_R1); float* st1 = (float*)(ws + WS_ST1); bf16_t* XF = (bf16_t*)(ws + WS_XF);
    const float* mod = (const float*)(ws + WS_MOD); const float* l1g = IN_F(I_LN1G); const float* l1b = IN_F(I_LN1B); const float* brt = IN_F(I_BR);
    int* toke = (int*)(ws + WS_TOKE); float* tokg = (float*)(ws + WS_TOKG); int* tokp = (int*)(ws + WS_TOKP);
    const int lane = F.lane;
    const int rows_per_blk = MTOK / F.G;
    const int row_base = F.vcu * rows_per_blk;
    for (int rl = F.wave * 2; rl < rows_per_blk; rl += NWAVES * 2) {
        f32x4 xv[2][4];
#pragma unroll
        for (int rr = 0; rr < 2; ++rr) {
            const int row = row_base + rl + rr; const int b = row >> 12;
            const f32x4* xr = (const f32x4*)(R1 + (size_t)row * D) + lane;
            f32x4 v[4]; float s = 0.f;
#pragma unroll
            for (int j = 0; j < 4; ++j) { v[j] = xr[64 * j]; s += (v[j][0] + v[j][1]) + (v[j][2] + v[j][3]); }
            const float mean = wave_sum(s) * (1.f / D); float s2 = 0.f;
#pragma unroll
            for (int j = 0; j < 4; ++j) { v[j] = v[j] - mean; s2 += (v[j][0] * v[j][0] + v[j][1] * v[j][1]) + (v[j][2] * v[j][2] + v[j][3] * v[j][3]); }
            const float rstd = 1.f / sqrtf(wave_sum(s2) * (1.f / D) + LN_EPS);
            if (lane == 0) { st1[row * 2] = mean; st1[row * 2 + 1] = rstd; }
            const f32x4* sh = (const f32x4*)(mod + b * 6144 + 3 * 1024) + lane; const f32x4* sc = (const f32x4*)(mod + b * 6144 + 4 * 1024) + lane;
            const f32x4* g4 = (const f32x4*)l1g + lane; const f32x4* b4 = (const f32x4*)l1b + lane;
            u32x2* o8 = (u32x2*)(XF + (size_t)row * D) + lane;
#pragma unroll
            for (int j = 0; j < 4; ++j) { const f32x4 h = v[j] * rstd * g4[64 * j] + b4[64 * j]; const f32x4 u = h * (sc[64 * j] + 1.f) + sh[64 * j]; xv[rr][j] = u;
                u32x2 w; w.x = cvtpk(u[0], u[1]); w.y = cvtpk(u[2], u[3]); o8[64 * j] = w; }
        }
        float lg0[32], lg1[32];
#pragma unroll
        for (int e = 0; e < 32; ++e) {
            float a0 = 0.f, a1 = 0.f;
#pragma unroll
            for (int j = 0; j < 4; ++j) { const f32x4 w = *(const LAS f32x4*)(wT + e * 1024 + 256 * j + 4 * lane);
                a0 += (xv[0][j][0] * w[0] + xv[0][j][1] * w[1]) + (xv[0][j][2] * w[2] + xv[0][j][3] * w[3]);
                a1 += (xv[1][j][0] * w[0] + xv[1][j][1] * w[1]) + (xv[1][j][2] * w[2] + xv[1][j][3] * w[3]); }
            lg0[e] = wave_sum(a0) + brt[e]; lg1[e] = wave_sum(a1) + brt[e];
        }
#pragma unroll
        for (int rr = 0; rr < 2; ++rr) {
            const int row = row_base + rl + rr;
            int te[4]; float tv[4];
#pragma unroll
            for (int k = 0; k < 4; ++k) {
                float best = -3.0e38f; int bi = 0;
#pragma unroll
                for (int e = 0; e < 32; ++e) { const float v = rr == 0 ? lg0[e] : lg1[e]; if (v > best) { best = v; bi = e; } }
#pragma unroll
                for (int e = 0; e < 32; ++e) { if (e == bi) { if (rr == 0) lg0[e] = -3.0e38f; else lg1[e] = -3.0e38f; } }
                te[k] = bi; tv[k] = best;
            }
            const float e1 = __expf(tv[1] - tv[0]), e2 = __expf(tv[2] - tv[0]), e3 = __expf(tv[3] - tv[0]); const float inv = 1.f / (1.f + e1 + e2 + e3);
            const float gk[4] = {inv, e1 * inv, e2 * inv, e3 * inv};
            if (lane < 4) {
                const int k = lane; const int e = k == 0 ? te[0] : k == 1 ? te[1] : k == 2 ? te[2] : te[3]; const float gv = k == 0 ? gk[0] : k == 1 ? gk[1] : k == 2 ? gk[2] : gk[3];
                const int pl = atomicAdd((int*)&cnt[e], 1);
                rinfo[(rl + rr) * 4 + k] = e | (pl << 8); rgate[(rl + rr) * 4 + k] = gv;
                toke[row * 4 + k] = e; tokg[row * 4 + k] = gv;
            }
        }
    }
    __syncthreads();
    if (F.tid < 32) base[F.tid] = (int)atomicAdd((unsigned*)(ws + WS_CTL) + CW_GCNT + F.tid, (unsigned)cnt[F.tid]);
    __syncthreads();
    if (F.tid < rows_per_blk * 4) {
        const int inf = rinfo[F.tid], e = inf & 255, pos = base[e] + (inf >> 8); const int row = row_base + (F.tid >> 2);
        ((int*)(ws + WS_LIST))[(size_t)e * LCAP + pos] = row; ((float*)(ws + WS_LGATE))[(size_t)e * LCAP + pos] = rgate[F.tid]; tokp[row * 4 + (F.tid & 3)] = pos;
    }
    __syncthreads();
}

__device__ __forceinline__ void moe_tab(Frame& F) {
    __syncthreads();
    if (F.tid == 0) { const unsigned* gc = (const unsigned*)(F.ws + WS_CTL) + CW_GCNT; int acc = 0;
        for (int e = 0; e < 32; ++e) { const int c = (int)__hip_atomic_load(gc + e, __ATOMIC_RELAXED, __HIP_MEMORY_SCOPE_AGENT); F.MISC[e] = acc; F.MISC[64 + e] = c; acc += (c + 255) >> 8; }
        F.MISC[32] = acc; }
    __syncthreads();
}

__device__ __forceinline__ void combine_phase(const Args& args, Frame& F) {
    unsigned char* ws = F.ws;
    const float* R1 = (const float*)(ws + WS_R1); const float* st1 = (const float*)(ws + WS_ST1); const bf16_t* YR = (const bf16_t*)(ws + WS_YR);
    const int* toke = (const int*)(ws + WS_TOKE); const int* tokp = (const int*)(ws + WS_TOKP); const float* mod = (const float*)(ws + WS_MOD);
    const float* l1g = IN_F(I_LN1G); const float* l1b = IN_F(I_LN1B); const float* l2g = IN_F(I_LN2G); const float* l2b = IN_F(I_LN2B);
    const int lane = F.lane; const int gw = F.vcu * NWAVES + F.wave, NGW = F.G * NWAVES;
    for (int row = gw; row < MTOK; row += NGW) {
        const int b = row >> 12; const float mean1 = st1[row * 2], rstd1 = st1[row * 2 + 1];
        f32x4 ff[4] = {f32x4{}, f32x4{}, f32x4{}, f32x4{}};
#pragma unroll
        for (int k = 0; k < 4; ++k) { const int e = toke[row * 4 + k], pos = tokp[row * 4 + k]; const size_t hr = (size_t)F.MISC[e] * 256 + pos;
            const u32x2* yp = (const u32x2*)(YR + hr * 1024) + lane;
#pragma unroll
            for (int j = 0; j < 4; ++j) { const u32x2 w = yp[64 * j]; ff[j][0] += bflo(w.x); ff[j][1] += bfhi(w.x); ff[j][2] += bflo(w.y); ff[j][3] += bfhi(w.y); } }
        const f32x4* xr = (const f32x4*)(R1 + (size_t)row * D) + lane; const f32x4* g2 = (const f32x4*)(mod + b * 6144 + 5 * 1024) + lane;
        const f32x4* g4 = (const f32x4*)l1g + lane; const f32x4* b4 = (const f32x4*)l1b + lane;
        f32x4 v[4]; float s = 0.f;
#pragma unroll
        for (int j = 0; j < 4; ++j) { const f32x4 h = (xr[64 * j] - mean1) * rstd1 * g4[64 * j] + b4[64 * j]; v[j] = h * DN_ALPHA + g2[64 * j] * ff[j]; s += (v[j][0] + v[j][1]) + (v[j][2] + v[j][3]); }
        const float mean = wave_sum(s) * (1.f / D); float s2 = 0.f;
#pragma unroll
        for (int j = 0; j < 4; ++j) { v[j] = v[j] - mean; s2 += (v[j][0] * v[j][0] + v[j][1] * v[j][1]) + (v[j][2] * v[j][2] + v[j][3] * v[j][3]); }
        const float rstd = 1.f / sqrtf(wave_sum(s2) * (1.f / D) + LN_EPS);
        const f32x4* og = (const f32x4*)l2g + lane; const f32x4* ob = (const f32x4*)l2b + lane; f32x4* op = (f32x4*)(args.out + (size_t)row * D) + lane;
#pragma unroll
        for (int j = 0; j < 4; ++j) op[64 * j] = v[j] * rstd * og[64 * j] + ob[64 * j];
    }
}


#define XB_TMO      128
#define XB_XCNT(j)  (256  + 64 * (j))
#define XB_XSUB(j)  (1280 + 64 * (j))
#define XB_XGEN(j)  (2304 + 64 * (j))
#define XB_TOP      3328
#define XB_TOPGEN   3392
#define XCD_BAR_WORDS 3456
#define XB_SPIN_CAP (1u << 20)
__device__ __forceinline__ unsigned xb_ld(unsigned* p)              { return __hip_atomic_load(p, __ATOMIC_RELAXED, __HIP_MEMORY_SCOPE_AGENT); }
__device__ __forceinline__ unsigned xb_add(unsigned* p, unsigned v) { return __hip_atomic_fetch_add(p, v, __ATOMIC_RELAXED, __HIP_MEMORY_SCOPE_AGENT); }
__device__ __forceinline__ unsigned xb_xcc_id() { return (unsigned)__builtin_amdgcn_s_getreg((3 << 11) | 20) & 0xFu; }
#define XB_SPIN(cond, bar) do { unsigned _sp = 0; while (cond) { __builtin_amdgcn_s_sleep(1); \
    if ((++_sp & 255u) == 0u) { if (xb_ld(&(bar)[XB_TMO])) break; if (_sp > XB_SPIN_CAP) { atomicAdd(&(bar)[XB_TMO], 1u); break; } } } } while (0)
struct XcdBarrier { unsigned* bar; unsigned x; volatile LAS unsigned* st; };
__device__ __forceinline__ XcdBarrier xcd_barrier_post(unsigned* bar, volatile LAS unsigned* st) {
    XcdBarrier b; b.bar = bar; b.x = xb_xcc_id(); b.st = st;
    if (threadIdx.x == 0) (void)xb_add(&bar[XB_XCNT(b.x)], 1u);
    return b;
}
__device__ __forceinline__ void xcd_barrier_complete(unsigned* bar, unsigned x, unsigned& nloc, unsigned& nx) {
    const unsigned G = gridDim.x * gridDim.y * gridDim.z;
    unsigned sum, cnt, mine, sp = 0u;
    for (;;) {
        sum = 0u; cnt = 0u; mine = 0u;
#pragma unroll
        for (unsigned j = 0; j < 16; ++j) { const unsigned c = xb_ld(&bar[XB_XCNT(j)]); sum += c; cnt += (c > 0u) ? 1u : 0u; mine = (j == x) ? c : mine; }
        if (sum == G) break;
        __builtin_amdgcn_s_sleep(1);
        if ((++sp & 255u) == 0u) { if (xb_ld(&bar[XB_TMO])) break; if (sp > XB_SPIN_CAP) { atomicAdd(&bar[XB_TMO], 1u); break; } }
    }
    nloc = mine > 0u ? mine : 1u; nx = cnt > 0u ? cnt : 1u;
}
__device__ __forceinline__ void xcd_barrier(const XcdBarrier& b) {
    asm volatile("s_waitcnt vmcnt(0)" ::: "memory");
    __syncthreads();
    if (threadIdx.x == 0) {
        unsigned* bar = b.bar;
        __builtin_amdgcn_s_waitcnt(0);
        unsigned nloc = b.st[0], nx = b.st[1];
        if (nloc == 0u) { xcd_barrier_complete(bar, b.x, nloc, nx); b.st[0] = nloc; b.st[1] = nx; }
        const unsigned old = xb_add(&bar[XB_XSUB(b.x)], 1u);
        const unsigned gen = old / nloc;
        if (old + 1u == (gen + 1u) * nloc) {
            __builtin_amdgcn_fence(__ATOMIC_RELEASE, "agent");
            asm volatile("s_waitcnt vmcnt(0)" ::: "memory");
            const unsigned og = xb_add(&bar[XB_TOP], 1u);
            const unsigned tg = og / nx;
            if (og + 1u == (tg + 1u) * nx) xb_add(&bar[XB_TOPGEN], 1u);
            else XB_SPIN(xb_ld(&bar[XB_TOPGEN]) == tg, bar);
            __builtin_amdgcn_fence(__ATOMIC_ACQUIRE, "agent");
            xb_add(&bar[XB_XGEN(b.x)], 1u);
            asm volatile("s_waitcnt vmcnt(0)" ::: "memory");
        } else {
            XB_SPIN(xb_ld(&bar[XB_XGEN(b.x)]) == gen, bar);
            __builtin_amdgcn_fence(__ATOMIC_ACQUIRE, "agent");
            asm volatile("s_waitcnt vmcnt(0)" ::: "memory");
        }
    }
    __syncthreads();
}

constexpr int N_PHASES = 14;
__global__ void __launch_bounds__(NTHR, 2) fwd_kernel(Args args) {
    extern __shared__ __attribute__((aligned(16))) unsigned char lds_raw[];
    Frame F;
    F.lds = (LAS unsigned char*)lds_raw; F.MISC = (volatile LAS int*)(F.lds + MISC_OFF);
    F.tid = threadIdx.x; F.lane = F.tid & 63; F.wave = __builtin_amdgcn_readfirstlane(F.tid >> 6);
    F.G = gridDim.x; { const int bx = blockIdx.x; F.vcu = (F.G % 8 == 0) ? (bx % 8) * (F.G / 8) + bx / 8 : bx; }
    F.ws = args.ws; F.a = &args;
    unsigned char* ws = args.ws;
    const int lo = args.ph_lo, hi = args.ph_hi;
#define IN(k) (lo <= (k) && (k) < hi)
#if MK_MULTI
#define GRID_BAR(k) do { } while (0)
#else
    if (F.tid < 2) F.MISC[1000 + F.tid] = 0;
    __syncthreads();
    const XcdBarrier xbar = xcd_barrier_post((unsigned*)(ws + WS_CTL) + CW_BAR, (volatile LAS unsigned*)(F.MISC + 1000));
#define GRID_BAR(k) do { if (IN((k) + 1)) xcd_barrier(xbar); } while (0)
#endif
    if (IN(0)) { p0_prep(args, F); GRID_BAR(0); }
    if (IN(1)) { p1_lnmod(args, F); GRID_BAR(1); }
    if (IN(2)) {
        SchedG1 S{(const char*)(ws + WS_U), (const char*)(ws + WS_WINT), F.G, F.vcu};
        EpiG1 E{(bf16_t*)(ws + WS_AP), (bf16_t*)(ws + WS_Q), (bf16_t*)(ws + WS_KB), (bf16_t*)(ws + WS_VB), (bf16_t*)(ws + WS_SGB), (bf16_t*)(ws + WS_SAB), (const float*)(ws + WS_ROPE)};
        pg8::gemm_phase<EpiG1, SchedG1, true>(F.lds, 1024, 2048u, S, E);
        GRID_BAR(2);
    }
    if (IN(3)) { attn_phase(args, F); }
    if (IN(4)) {
        SchedS5L S{(const char*)(ws + WS_AP), (const char*)(ws + WS_BTL), F.G, F.vcu};
        EpiS5L E{(float*)(ws + WS_LBUF)};
        pg8::gemm_phase<EpiS5L, SchedS5L, true>(F.lds, 512, (unsigned)(SK * 2), S, E);
        GRID_BAR(4);
    }
    if (IN(5)) { scan_phase(args, F); GRID_BAR(5); }
    if (IN(6)) {
        SchedS5Y S{(const char*)(ws + WS_AP), (const char*)(ws + WS_BTY), F.G, F.vcu};
        EpiS5Y E{(bf16_t*)(ws + WS_Z)};
        pg8::gemm_phase<EpiS5Y, SchedS5Y, true>(F.lds, 768, (unsigned)(SK * 2), S, E);
        GRID_BAR(6);
    }
    if (IN(7)) {
        SchedPlain S{(const char*)(ws + WS_Z), (const char*)(ws + WS_WGLUT), 64, 2, 512, F.G, F.vcu};
        EpiGLU E{(const bf16_t*)(ws + WS_Z), (bf16_t*)(ws + WS_Z2), IN_F(I_BGLU)};
        pg8::gemm_phase<EpiGLU, SchedPlain, true>(F.lds, 512, 1024u, S, E);
        GRID_BAR(7);
    }
    if (IN(8)) {
        SchedMerge S{(const char*)(ws + WS_Z2), (const char*)(ws + WS_OATT), (const char*)(ws + WS_WSOT), (const char*)(ws + WS_WAOT), F.G, F.vcu};
        EpiMerge E{(const bf16_t*)(ws + WS_SGB), (const bf16_t*)(ws + WS_SAB), (float*)(ws + WS_TMP), (bf16_t*)(ws + WS_MB)};
        pg8::gemm_phase<EpiMerge, SchedMerge, true>(F.lds, 512, 1024u, S, E);
        GRID_BAR(8);
    }
    if (IN(9)) {
        SchedPlain S{(const char*)(ws + WS_MB), (const char*)(ws + WS_WOT), 64, 4, 1024, F.G, F.vcu};
        EpiWO E{IN_F(I_X), (const float*)(ws + WS_ST0), IN_F(I_LNG), IN_F(I_LNB), (const float*)(ws + WS_MOD), (float*)(ws + WS_R1)};
        pg8::gemm_phase<EpiWO, SchedPlain, true>(F.lds, 1024, 2048u, S, E);
        GRID_BAR(9);
    }
    if (IN(10)) { router_phase(args, F); GRID_BAR(10); }
    if (IN(11)) {
        moe_tab(F);
        SchedMoe<8, true> S{(const char*)(ws + WS_XF), (const char*)(ws + WS_WGUT), (const int*)(ws + WS_LIST), MoeTab{F.MISC}, F.G, F.vcu};
        EpiMoe1 E{(bf16_t*)(ws + WS_H), IN_F(I_BGU)};
        pg8::gemm_phase<EpiMoe1, SchedMoe<8, true>, true>(F.lds, 1024, 2048u, S, E);
        GRID_BAR(11);
    }
    if (IN(12)) {
        moe_tab(F);
        SchedMoe<4, false> S{(const char*)(ws + WS_H), (const char*)(ws + WS_WDT), (const int*)(ws + WS_LIST), MoeTab{F.MISC}, F.G, F.vcu};
        EpiMoe2 E{(bf16_t*)(ws + WS_YR), IN_F(I_BD), (const float*)(ws + WS_LGATE), MoeTab{F.MISC}};
        pg8::gemm_phase<EpiMoe2, SchedMoe<4, false>, true>(F.lds, 1024, 2048u, S, E);
        GRID_BAR(12);
    }
    if (IN(13)) { moe_tab(F); combine_phase(args, F); }
#undef IN
#undef GRID_BAR
}

extern "C" void kernel_launch(void* const* d_in, const int* in_sizes, int n_in, void* d_out, int out_size, void* d_ws, size_t ws_size, hipStream_t stream) {
    static int grid = 0;
    if (grid == 0) {
        if (n_in != 33 || in_sizes[0] != MTOK * D || out_size != MTOK * D || ws_size < WS_END) { fprintf(stderr, "kernel_launch: unexpected shapes (n_in %d, ws %zu)\n", n_in, ws_size); grid = -1; return; }
        int dev = 0, cus = 0, per_cu = 0;
        if (hipGetDevice(&dev) != hipSuccess || hipDeviceGetAttribute(&cus, hipDeviceAttributeMultiprocessorCount, dev) != hipSuccess) { grid = -1; return; }
        if (hipFuncSetAttribute((const void*)fwd_kernel, hipFuncAttributeMaxDynamicSharedMemorySize, LDS_BYTES) != hipSuccess) { fprintf(stderr, "kernel_launch: hipFuncSetAttribute failed\n"); grid = -1; return; }
        if (hipOccupancyMaxActiveBlocksPerMultiprocessor(&per_cu, (const void*)fwd_kernel, NTHR, LDS_BYTES) != hipSuccess || per_cu < 1) { fprintf(stderr, "kernel_launch: occupancy query says %d\n", per_cu); (void)hipGetLastError(); grid = -1; return; }
        if (cus < 256) { fprintf(stderr, "kernel_launch: needs 256 CUs, device has %d\n", cus); grid = -1; return; }
        grid = 256;
    }
    if (grid < 0) return;
    (void)hipMemsetAsync((char*)d_ws + WS_CTL, 0, CTL_BYTES, stream);
    Args a{};
    for (int i = 0; i < 33; ++i) a.in[i] = d_in[i];
    a.out = (float*)d_out; a.ws = (unsigned char*)d_ws;
#if MK_MULTI
    for (int p = 0; p < N_PHASES; ++p) { a.ph_lo = p; a.ph_hi = p + 1; hipLaunchKernelGGL(fwd_kernel, dim3(grid), dim3(NTHR), LDS_BYTES, stream, a); }
#else
    a.ph_lo = 0; a.ph_hi = N_PHASES;
    void* kargs[] = {&a};
    hipError_t e = hipLaunchCooperativeKernel((const void*)fwd_kernel, dim3(grid), dim3(NTHR), kargs, LDS_BYTES, stream);
    if (e != hipSuccess) fprintf(stderr, "kernel_launch: cooperative launch failed: %s\n", hipGetErrorString(e));
#endif
}
```

```cpp
#include <hip/hip_runtime.h>
#include <hip/hip_cooperative_groups.h>
#include <cstdint>
#include <cstdio>
namespace cg = cooperative_groups;

#ifndef MK_MULTI
#define MK_MULTI 0
#endif

#define LAS __attribute__((address_space(3)))
#define GAS __attribute__((address_space(1)))
typedef unsigned short bf16_t;
typedef short bf16x8 __attribute__((ext_vector_type(8)));
typedef float f32x4 __attribute__((ext_vector_type(4)));
typedef float f32x2 __attribute__((ext_vector_type(2)));
typedef float f32x16 __attribute__((ext_vector_type(16)));
typedef unsigned u32x4 __attribute__((ext_vector_type(4)));
typedef unsigned u32x2 __attribute__((ext_vector_type(2)));
typedef __bf16 bf16x2_t __attribute__((ext_vector_type(2)));

constexpr int D = 1024, NB = 4, SEQ = 4096, CTX = 256;
constexpr int MTOK = NB * SEQ;
constexpr int MCTX = NB * CTX;
constexpr int MALL = MTOK + MCTX;
constexpr int INC = 3328;
constexpr int NE = 32, FE = 1024;
constexpr int SG = 32, SP = 64, SH = 16, CH = 32;
constexpr int SROWS = 768;
constexpr int SK = 768;
constexpr float LN_EPS = 1e-5f;
constexpr float DN_ALPHA = 1.189207115002721f;
constexpr float LOG2E = 1.4426950408889634f;
constexpr int LCAP = 16384;
constexpr int HCAP = 65536 + NE * 256;

constexpr size_t MiB = 1u << 20;
constexpr size_t WS_CTL = 0, CTL_BYTES = 1 * MiB;
constexpr size_t WS_MOD = 1 * MiB;
constexpr size_t WS_ROPE = 1 * MiB + 128 * 1024;
constexpr size_t WS_ST0 = 1 * MiB + 256 * 1024;
constexpr size_t WS_ST1 = 1 * MiB + 512 * 1024;
constexpr size_t WS_TOKE = 2 * MiB;
constexpr size_t WS_TOKP = 2 * MiB + 256 * 1024;
constexpr size_t WS_TOKG = 2 * MiB + 512 * 1024;
constexpr size_t WS_LIST = 3 * MiB;
constexpr size_t WS_LGATE = 5 * MiB;
constexpr size_t WS_WINT = 8 * MiB;
constexpr size_t WS_WGLUT = 15 * MiB;
constexpr size_t WS_WSOT = 16 * MiB;
constexpr size_t WS_WAOT = 17 * MiB;
constexpr size_t WS_WOT = 18 * MiB;
constexpr size_t WS_BTL = 20 * MiB;
constexpr size_t WS_BTY = 28 * MiB;
constexpr size_t WS_WGUT = 52 * MiB;
constexpr size_t WS_WDT = 180 * MiB;
constexpr size_t WS_R1 = 244 * MiB;
constexpr size_t WS_XF = 308 * MiB;
constexpr size_t WS_U = 340 * MiB;
constexpr size_t WS_AP = 374 * MiB;
constexpr size_t WS_Q = 410 * MiB;
constexpr size_t WS_KB = 426 * MiB;
constexpr size_t WS_VB = 431 * MiB;
constexpr size_t WS_SGB = 436 * MiB;
constexpr size_t WS_SAB = 468 * MiB;
constexpr size_t WS_LBUF = 500 * MiB;
constexpr size_t WS_Z = 524 * MiB;
constexpr size_t WS_Z2 = 540 * MiB;
constexpr size_t WS_OATT = 556 * MiB;
constexpr size_t WS_TMP = 572 * MiB;
constexpr size_t WS_MB = 636 * MiB;
constexpr size_t WS_H = 340 * MiB;
constexpr size_t WS_YR = 484 * MiB;
constexpr size_t WS_END = 668 * MiB;
static_assert(WS_H + (size_t)HCAP * 1024 * 2 <= WS_YR && WS_YR + (size_t)HCAP * 1024 * 2 <= WS_MB, "MoE overlay");
constexpr int CW_GCNT = 64;
constexpr int CW_BAR = 4096;

constexpr int RING_BYTES = 131072;
constexpr int MISC_OFF = RING_BYTES;
constexpr int LDS_BYTES = 147456;
constexpr int NWAVES = 8, NTHR = 512;

__device__ __forceinline__ unsigned cvtpk(float lo, float hi) { f32x2 v = {lo, hi}; bf16x2_t b = __builtin_convertvector(v, bf16x2_t); return __builtin_bit_cast(unsigned, b); }
__device__ __forceinline__ float bf2f(unsigned short h) { return __uint_as_float((unsigned)h << 16); }
__device__ __forceinline__ float bflo(unsigned w) { return __uint_as_float(w << 16); }
__device__ __forceinline__ float bfhi(unsigned w) { return __uint_as_float(w & 0xffff0000u); }
__device__ __forceinline__ float sigmoidf_(float v) { return __builtin_amdgcn_rcpf(1.f + __expf(-v)); }
__device__ __forceinline__ float wave_sum(float v) {
#pragma unroll
    for (int o = 1; o < 64; o <<= 1) v += __shfl_xor(v, o);
    return v;
}
#define LDS_WAIT() asm volatile("s_waitcnt lgkmcnt(0)" ::: "memory")
#define VM_WAIT() asm volatile("s_waitcnt vmcnt(0)" ::: "memory")

namespace pg8 {
constexpr int BM = 256, BK = 64, HALF = 128, HTB = HALF * BK * 2, STAGE_BYTES = 8 * HTB;
__device__ __forceinline__ int lds_byte(int r, int c) { const int st = (r >> 4) * 2 + (c >> 5), rr = r & 15, cc = c & 31, ob = rr * 64 + cc * 2; return st * 1024 + (ob ^ (((ob >> 9) & 1) << 5)); }
__device__ __forceinline__ void stage_rc(int b, int& R, int& C) { const int st = b / 1024, sb = b % 1024, swz = sb ^ (((sb >> 9) & 1) << 5); R = (st >> 1) * 16 + swz / 64; C = (st & 1) * 32 + (swz % 64) / 2; }
__device__ __forceinline__ int perm32(int rho) { const int n = rho >> 4, i = rho & 15; return 8 * (i >> 2) + 4 * n + (i & 3); }

struct Unit { const char* a; const char* b; int pm, pn, aux; };

template <class Epi, class Sched, bool ALIGN_EPI>
__device__ __forceinline__ void gemm_phase(LAS unsigned char* lds, const int K, const unsigned lda2, const Sched& S, const Epi& E) {
    const int tid = threadIdx.x, wid = __builtin_amdgcn_readfirstlane(tid >> 6), lane = tid & 63, wr = wid >> 2, wc = wid & 3, fr = lane & 15, fq = lane >> 4;
    const int nt = K / BK;
    int Rl[2], Cl[2]; unsigned voffB[2];
#pragma unroll
    for (int i = 0; i < 2; ++i) { stage_rc(tid * 16 + i * 8192, Rl[i], Cl[i]); const int Rb = Epi::PERM ? ((Rl[i] & ~31) + perm32(Rl[i] & 31)) : Rl[i]; voffB[i] = (unsigned)(Rb * K + Cl[i]) * 2u; }
    const size_t kstep = (size_t)(BK * 2);
    const size_t hstepB = (size_t)HALF * K * 2;
    const unsigned ldsw = (unsigned)wid * 1024u;
    const int aoff = lds_byte(wr * 64 + fr, fq * 8), boff = lds_byte(wc * 32 + fr, fq * 8);
#define PG8_SA(b, h) (((b) * 2 + (h)) * HTB)
#define PG8_SB(b, h) ((4 + (b) * 2 + (h)) * HTB)
#define PG8_STAGE(bufoff, gbase, v0, v1) do { \
        __builtin_amdgcn_global_load_lds((const unsigned*)((const char*)(gbase) + (v0)), (LAS unsigned*)(lds + (bufoff) + ldsw), 16, 0, 0); \
        __builtin_amdgcn_global_load_lds((const unsigned*)((const char*)(gbase) + (v1)), (LAS unsigned*)(lds + (bufoff) + ldsw + 8192), 16, 0, 0); } while (0)
#define PG8_STAGEB(bufoff, gbase) PG8_STAGE(bufoff, gbase, voffB[0], voffB[1])
#define PG8_LDA(dst, b, h) do { _Pragma("unroll") for (int m = 0; m < 4; ++m) _Pragma("unroll") for (int k = 0; k < 2; ++k) dst[m][k] = *(const LAS bf16x8*)(lds + PG8_SA(b, h) + aoff + m * 2048 + k * 1024); } while (0)
#define PG8_LDB(dst, b, h) do { _Pragma("unroll") for (int n = 0; n < 2; ++n) _Pragma("unroll") for (int k = 0; k < 2; ++k) dst[n][k] = *(const LAS bf16x8*)(lds + PG8_SB(b, h) + boff + n * 2048 + k * 1024); } while (0)
#define PG8_MMA(ai, bj, At, Bt) do { __builtin_amdgcn_s_setprio(1); _Pragma("unroll") for (int m = 0; m < 4; ++m) _Pragma("unroll") for (int n = 0; n < 2; ++n) _Pragma("unroll") for (int k = 0; k < 2; ++k) \
        acc[ai][bj][m][n] = __builtin_amdgcn_mfma_f32_16x16x32_bf16(Bt[n][k], At[m][k], acc[ai][bj][m][n], 0, 0, 0); __builtin_amdgcn_s_setprio(0); } while (0)
#define PG8_WAIT_V(n) asm volatile("s_waitcnt vmcnt(" #n ")" ::: "memory")
#define PG8_WAIT_L(n) asm volatile("s_waitcnt lgkmcnt(" #n ")" ::: "memory")
#define PG8_BAR __builtin_amdgcn_s_barrier()
#define PG8_SCHED __builtin_amdgcn_sched_barrier(0)
#define PG8_SETA(v, u) do { _Pragma("unroll") for (int h_ = 0; h_ < 2; ++h_) _Pragma("unroll") for (int i_ = 0; i_ < 2; ++i_) { \
        const unsigned row_ = Sched::GATHER ? S.arow(u, h_ * HALF + Rl[i_]) : (unsigned)(h_ * HALF + Rl[i_]); v[h_][i_] = row_ * lda2 + (unsigned)Cl[i_] * 2u; } } while (0)
    Unit cur, nxt; int ui = 0;
    if (!S.next(0, cur)) return;
    f32x4 acc[2][2][4][2];
#pragma unroll
    for (int a = 0; a < 2; ++a)
#pragma unroll
        for (int b = 0; b < 2; ++b)
#pragma unroll
            for (int m = 0; m < 4; ++m)
#pragma unroll
                for (int n = 0; n < 2; ++n) acc[a][b][m][n] = (f32x4){0.f, 0.f, 0.f, 0.f};
    bf16x8 At[4][2], B0[2][2], B1[2][2];
    unsigned vc[2][2], vn[2][2];
    PG8_SETA(vc, cur);
    const char* cA = cur.a; const char* cB = cur.b;
    PG8_STAGEB(PG8_SB(0, 0), cB); PG8_STAGEB(PG8_SB(0, 1), cB + hstepB); PG8_STAGE(PG8_SA(0, 0), cA, vc[0][0], vc[0][1]); PG8_STAGE(PG8_SA(0, 1), cA, vc[1][0], vc[1][1]);
    if (wr == 1) PG8_BAR;
    PG8_WAIT_V(2); PG8_BAR;
    PG8_STAGEB(PG8_SB(1, 0), cB + kstep); PG8_STAGE(PG8_SA(1, 0), cA + kstep, vc[0][0], vc[0][1]); PG8_STAGEB(PG8_SB(1, 1), cB + hstepB + kstep);
    PG8_WAIT_V(6); PG8_BAR;
    for (;;) {
        const bool has_next = S.next(ui + 1, nxt);
        const char* nA = has_next ? nxt.a : cA; const char* nB = has_next ? nxt.b : cB;
        if (Sched::GATHER) { if (has_next) { PG8_SETA(vn, nxt); } else {
#pragma unroll
            for (int h = 0; h < 2; ++h) { vn[h][0] = vc[h][0]; vn[h][1] = vc[h][1]; } } }
        for (int t = 0; t < nt; t += 2) {
            const bool last = (t == nt - 2);
            const char* a1 = cA + (size_t)(t + 1) * kstep;
            const char* a2 = last ? nA : cA + (size_t)(t + 2) * kstep; const char* b2 = last ? nB : cB + (size_t)(t + 2) * kstep;
            const char* a3 = a2 + kstep; const char* b3 = b2 + kstep;
            unsigned v2[2][2];
#pragma unroll
            for (int h = 0; h < 2; ++h) { v2[h][0] = (Sched::GATHER && last) ? vn[h][0] : vc[h][0]; v2[h][1] = (Sched::GATHER && last) ? vn[h][1] : vc[h][1]; }
            PG8_LDB(B0, 0, 0); PG8_LDB(B1, 0, 1); PG8_SCHED; PG8_LDA(At, 0, 0); PG8_STAGE(PG8_SA(1, 1), a1, vc[1][0], vc[1][1]);
            PG8_WAIT_V(8); PG8_WAIT_L(0); PG8_BAR; PG8_MMA(0, 0, At, B0); PG8_MMA(0, 1, At, B1); PG8_BAR; PG8_SCHED;
            PG8_LDA(At, 0, 1); PG8_STAGEB(PG8_SB(0, 0), b2); PG8_STAGEB(PG8_SB(0, 1), b2 + hstepB); PG8_STAGE(PG8_SA(0, 0), a2, v2[0][0], v2[0][1]);
            PG8_WAIT_V(8); PG8_WAIT_L(0); PG8_BAR; PG8_MMA(1, 0, At, B0); PG8_MMA(1, 1, At, B1); PG8_BAR; PG8_SCHED;
            PG8_LDB(B0, 1, 0); PG8_LDB(B1, 1, 1); PG8_SCHED; PG8_LDA(At, 1, 0); PG8_STAGE(PG8_SA(0, 1), a2, v2[1][0], v2[1][1]);
            PG8_WAIT_V(8); PG8_WAIT_L(0); PG8_BAR; PG8_MMA(0, 0, At, B0); PG8_MMA(0, 1, At, B1); PG8_BAR; PG8_SCHED;
            PG8_LDA(At, 1, 1); PG8_STAGEB(PG8_SB(1, 0), b3); PG8_STAGEB(PG8_SB(1, 1), b3 + hstepB); PG8_STAGE(PG8_SA(1, 0), a3, v2[0][0], v2[0][1]);
            PG8_WAIT_V(8); PG8_WAIT_L(0); PG8_BAR; PG8_MMA(1, 0, At, B0); PG8_MMA(1, 1, At, B1); PG8_BAR; PG8_SCHED;
        }
        if constexpr (ALIGN_EPI) { if (wr == 0) PG8_BAR; }
        E(acc, cur, wr, wc, fr, fq);
        if (!has_next) break;
#pragma unroll
        for (int a = 0; a < 2; ++a)
#pragma unroll
            for (int b = 0; b < 2; ++b)
#pragma unroll
                for (int m = 0; m < 4; ++m)
#pragma unroll
                    for (int n = 0; n < 2; ++n) acc[a][b][m][n] = (f32x4){0.f, 0.f, 0.f, 0.f};
        cur = nxt; cA = nA; cB = nB; ++ui;
        if (Sched::GATHER) {
#pragma unroll
            for (int h = 0; h < 2; ++h) { vc[h][0] = vn[h][0]; vc[h][1] = vn[h][1]; } }
        if constexpr (ALIGN_EPI) { if (wr == 1) PG8_BAR; }
    }
    PG8_WAIT_V(0);
    if constexpr (!ALIGN_EPI) { if (wr == 0) PG8_BAR; }
    PG8_BAR;
#undef PG8_SA
#undef PG8_SB
#undef PG8_STAGE
#undef PG8_STAGEB
#undef PG8_LDA
#undef PG8_LDB
#undef PG8_MMA
#undef PG8_WAIT_V
#undef PG8_WAIT_L
#undef PG8_BAR
#undef PG8_SCHED
#undef PG8_SETA
}
}

using pg8::Unit;
__device__ __forceinline__ float gelu_tanh(float x) {
    const float t = 1.5957691216057308f * (x + 0.044715f * x * x * x);
    return x * __builtin_amdgcn_rcpf(1.f + __expf(-t));
}
__device__ __forceinline__ u32x4 pack8(const f32x4 a, const f32x4 b) { u32x4 w; w.x = cvtpk(a[0], a[1]); w.y = cvtpk(a[2], a[3]); w.z = cvtpk(b[0], b[1]); w.w = cvtpk(b[2], b[3]); return w; }

struct EpiG1 {
    static constexpr bool PERM = true;
    bf16_t *AP, *Q, *KB, *VB, *SGB, *SAB; const float* rope;
    __device__ __forceinline__ void operator()(const f32x4 (&acc)[2][2][4][2], const Unit& u, int wr, int wc, int fr, int fq) const {
        const int pn = u.pn;
#pragma unroll
        for (int ai = 0; ai < 2; ++ai)
#pragma unroll
            for (int m = 0; m < 4; ++m) {
                const int row = u.pm * 256 + ai * 128 + wr * 64 + m * 16 + fr;
#pragma unroll
                for (int bj = 0; bj < 2; ++bj) {
                    const int col = pn * 256 + bj * 128 + wc * 32 + 8 * fq;
                    f32x4 v0 = acc[ai][bj][m][0], v1 = acc[ai][bj][m][1];
                    if (pn < 2) {
                        const int g = col >> 4, h0 = col & 15;
                        const int crow = row < MTOK ? (row >> 5) : (512 + ((row - MTOK) >> 5));
                        *(u32x4*)(AP + ((size_t)(g * SROWS + crow) * SK + (row & 31) * 16 + h0)) = pack8(v0, v1);
                    } else if (pn < 4 || (pn == 4 && bj == 0)) {
                        const bool isq = pn < 4;
                        const int cc = isq ? (col - 512) : (col - 1024);
                        if (row < MTOK) {
                            const int hc = cc & 63, i0 = hc >> 1;
                            const int t = row & (SEQ - 1);
                            const int pos = (i0 < 16) ? (t >> 6) : (t & 63);
                            const float* rp = rope + (pos * 16 + (i0 & 15)) * 2;
                            const f32x4 cs0 = *(const f32x4*)rp, cs1 = *(const f32x4*)(rp + 4);
                            f32x4 o0, o1;
                            o0[0] = v0[0] * cs0[0] - v0[1] * cs0[1]; o0[1] = v0[1] * cs0[0] + v0[0] * cs0[1];
                            o0[2] = v0[2] * cs0[2] - v0[3] * cs0[3]; o0[3] = v0[3] * cs0[2] + v0[2] * cs0[3];
                            o1[0] = v1[0] * cs1[0] - v1[1] * cs1[1]; o1[1] = v1[1] * cs1[0] + v1[0] * cs1[1];
                            o1[2] = v1[2] * cs1[2] - v1[3] * cs1[3]; o1[3] = v1[3] * cs1[2] + v1[2] * cs1[3];
                            v0 = o0; v1 = o1;
                        }
                        if (isq) { const float sc = 0.125f * LOG2E; v0 = v0 * sc; v1 = v1 * sc; *(u32x4*)(Q + ((size_t)row * 512 + cc)) = pack8(v0, v1); }
                        else *(u32x4*)(KB + ((size_t)row * 128 + cc)) = pack8(v0, v1);
                    } else if (pn == 4) {
                        *(u32x4*)(VB + ((size_t)row * 128 + (col - 1152))) = pack8(v0, v1);
                    } else {
#pragma unroll
                        for (int e = 0; e < 4; ++e) { v0[e] = sigmoidf_(v0[e]); v1[e] = sigmoidf_(v1[e]); }
                        if (pn < 9) *(u32x4*)(SGB + ((size_t)row * 1024 + (col - 1280))) = pack8(v0, v1);
                        else *(u32x4*)(SAB + ((size_t)row * 1024 + (col - 2304))) = pack8(v0, v1);
                    }
                }
            }
    }
};
struct EpiS5L {
    static constexpr bool PERM = false;
    float* L;
    __device__ __forceinline__ void operator()(const f32x4 (&acc)[2][2][4][2], const Unit& u, int wr, int wc, int fr, int fq) const {
#pragma unroll
        for (int ai = 0; ai < 2; ++ai)
#pragma unroll
            for (int m = 0; m < 4; ++m) {
                const int row = u.pm * 256 + ai * 128 + wr * 64 + m * 16 + fr;
                float* rp = L + ((size_t)(u.aux * SROWS + row) * 256 + wc * 32 + 4 * fq);
#pragma unroll
                for (int bj = 0; bj < 2; ++bj)
#pragma unroll
                    for (int n = 0; n < 2; ++n) *(f32x4*)(rp + bj * 128 + n * 16) = acc[ai][bj][m][n];
            }
    }
};
struct EpiS5Y {
    static constexpr bool PERM = true;
    bf16_t* Z;
    __device__ __forceinline__ void operator()(const f32x4 (&acc)[2][2][4][2], const Unit& u, int wr, int wc, int fr, int fq) const {
#pragma unroll
        for (int ai = 0; ai < 2; ++ai)
#pragma unroll
            for (int m = 0; m < 4; ++m) {
                const int crow = u.pm * 256 + ai * 128 + wr * 64 + m * 16 + fr;
#pragma unroll
                for (int bj = 0; bj < 2; ++bj) {
                    const int col = u.pn * 256 + bj * 128 + wc * 32 + 8 * fq;
                    const int tok = crow * 32 + (col >> 4);
                    f32x4 v0 = acc[ai][bj][m][0], v1 = acc[ai][bj][m][1];
#pragma unroll
                    for (int e = 0; e < 4; ++e) { v0[e] = gelu_tanh(v0[e]); v1[e] = gelu_tanh(v1[e]); }
                    *(u32x4*)(Z + ((size_t)tok * 512 + u.aux * 16 + (col & 15))) = pack8(v0, v1);
                }
            }
    }
};
struct EpiGLU {
    static constexpr bool PERM = true;
    const bf16_t* Z; bf16_t* Z2; const float* bias;
    __device__ __forceinline__ void operator()(const f32x4 (&acc)[2][2][4][2], const Unit& u, int wr, int wc, int fr, int fq) const {
#pragma unroll
        for (int bj = 0; bj < 2; ++bj) {
            const int col = u.pn * 256 + bj * 128 + wc * 32 + 8 * fq;
            const f32x4 b0 = *(const f32x4*)(bias + col), b1 = *(const f32x4*)(bias + col + 4);
#pragma unroll
            for (int ai = 0; ai < 2; ++ai)
#pragma unroll
                for (int m = 0; m < 4; ++m) {
                    const int row = u.pm * 256 + ai * 128 + wr * 64 + m * 16 + fr;
                    const u32x4 zz = *(const u32x4*)(Z + ((size_t)row * 512 + col));
                    f32x4 v0 = acc[ai][bj][m][0] + b0, v1 = acc[ai][bj][m][1] + b1;
                    v0[0] = bflo(zz.x) * sigmoidf_(v0[0]); v0[1] = bfhi(zz.x) * sigmoidf_(v0[1]); v0[2] = bflo(zz.y) * sigmoidf_(v0[2]); v0[3] = bfhi(zz.y) * sigmoidf_(v0[3]);
                    v1[0] = bflo(zz.z) * sigmoidf_(v1[0]); v1[1] = bfhi(zz.z) * sigmoidf_(v1[1]); v1[2] = bflo(zz.w) * sigmoidf_(v1[2]); v1[3] = bfhi(zz.w) * sigmoidf_(v1[3]);
                    *(u32x4*)(Z2 + ((size_t)row * 512 + col)) = pack8(v0, v1);
                }
        }
    }
};
struct EpiMerge {
    static constexpr bool PERM = false;
    const bf16_t *SGB, *SAB; float* TMP; bf16_t* MB;
    __device__ __forceinline__ void operator()(const f32x4 (&acc)[2][2][4][2], const Unit& u, int wr, int wc, int fr, int fq) const {
        const bf16_t* gsrc = u.aux ? SAB : SGB;
#pragma unroll
        for (int ai = 0; ai < 2; ++ai)
#pragma unroll
            for (int m = 0; m < 4; ++m) {
                const int row = u.pm * 256 + ai * 128 + wr * 64 + m * 16 + fr;
#pragma unroll
                for (int bj = 0; bj < 2; ++bj)
#pragma unroll
                    for (int n = 0; n < 2; ++n) {
                        const size_t off = (size_t)row * 1024 + u.pn * 256 + bj * 128 + wc * 32 + n * 16 + 4 * fq;
                        const u32x2 gg = *(const u32x2*)(gsrc + off);
                        f32x4 v = acc[ai][bj][m][n];
                        v[0] *= bflo(gg.x); v[1] *= bfhi(gg.x); v[2] *= bflo(gg.y); v[3] *= bfhi(gg.y);
                        if (u.aux == 0) *(f32x4*)(TMP + off) = v;
                        else { v = v + *(const f32x4*)(TMP + off); u32x2 w; w.x = cvtpk(v[0], v[1]); w.y = cvtpk(v[2], v[3]); *(u32x2*)(MB + off) = w; }
                    }
            }
    }
};
struct EpiWO {
    static constexpr bool PERM = false;
    const float *x, *st0, *lg, *lb, *mod; float* R1;
    __device__ __forceinline__ void operator()(const f32x4 (&acc)[2][2][4][2], const Unit& u, int wr, int wc, int fr, int fq) const {
        const int b = u.pm >> 4;
        const float* g1 = mod + b * 6144 + 2 * 1024;
#pragma unroll
        for (int bj = 0; bj < 2; ++bj)
#pragma unroll
            for (int n = 0; n < 2; ++n) {
                const int col = u.pn * 256 + bj * 128 + wc * 32 + n * 16 + 4 * fq;
                const f32x4 gv = *(const f32x4*)(g1 + col), lgv = *(const f32x4*)(lg + col), lbv = *(const f32x4*)(lb + col);
#pragma unroll
                for (int ai = 0; ai < 2; ++ai)
#pragma unroll
                    for (int m = 0; m < 4; ++m) {
                        const int row = u.pm * 256 + ai * 128 + wr * 64 + m * 16 + fr;
                        const f32x2 st = *(const f32x2*)(st0 + row * 2);
                        const f32x4 xv = *(const f32x4*)(x + (size_t)row * 1024 + col);
                        const f32x4 h = (xv - st.x) * st.y * lgv + lbv;
                        *(f32x4*)(R1 + (size_t)row * 1024 + col) = h * DN_ALPHA + gv * acc[ai][bj][m][n];
                    }
            }
    }
};
struct MoeTab { volatile LAS int* t; };
struct EpiMoe1 {
    static constexpr bool PERM = true;
    bf16_t* H; const float* bgu;
    __device__ __forceinline__ void operator()(const f32x4 (&acc)[2][2][4][2], const Unit& u, int wr, int wc, int fr, int fq) const {
        const int f0 = u.pn * 128 + wc * 32 + 8 * fq;
        const float* bp = bgu + (size_t)u.aux * 2048 + f0;
        const f32x4 bg0 = *(const f32x4*)bp, bg1 = *(const f32x4*)(bp + 4), bl0 = *(const f32x4*)(bp + 1024), bl1 = *(const f32x4*)(bp + 1028);
#pragma unroll
        for (int ai = 0; ai < 2; ++ai)
#pragma unroll
            for (int m = 0; m < 4; ++m) {
                const int row = u.pm * 256 + ai * 128 + wr * 64 + m * 16 + fr;
                f32x4 g0 = acc[ai][0][m][0] + bg0, g1 = acc[ai][0][m][1] + bg1, l0 = acc[ai][1][m][0] + bl0, l1 = acc[ai][1][m][1] + bl1;
#pragma unroll
                for (int e = 0; e < 4; ++e) {
                    float ga = fminf(g0[e], 7.f), la = fminf(fmaxf(l0[e], -7.f), 7.f); g0[e] = ga * sigmoidf_(1.702f * ga) * (la + 1.f);
                    ga = fminf(g1[e], 7.f); la = fminf(fmaxf(l1[e], -7.f), 7.f); g1[e] = ga * sigmoidf_(1.702f * ga) * (la + 1.f);
                }
                *(u32x4*)(H + ((size_t)row * 1024 + f0)) = pack8(g0, g1);
            }
    }
};
struct EpiMoe2 {
    static constexpr bool PERM = true;
    bf16_t* YR; const float* bd; const float* lgate; MoeTab tab;
    __device__ __forceinline__ void operator()(const f32x4 (&acc)[2][2][4][2], const Unit& u, int wr, int wc, int fr, int fq) const {
        const int e = u.aux, rt = u.pm - tab.t[e], cnt = tab.t[64 + e];
#pragma unroll
        for (int bj = 0; bj < 2; ++bj) {
            const int col = u.pn * 256 + bj * 128 + wc * 32 + 8 * fq;
            const f32x4 b0 = *(const f32x4*)(bd + (size_t)e * 1024 + col), b1 = *(const f32x4*)(bd + (size_t)e * 1024 + col + 4);
#pragma unroll
            for (int ai = 0; ai < 2; ++ai)
#pragma unroll
                for (int m = 0; m < 4; ++m) {
                    const int lr = ai * 128 + wr * 64 + m * 16 + fr, idx = rt * 256 + lr;
                    const float gt = idx < cnt ? lgate[(size_t)e * LCAP + idx] : 0.f;
                    const f32x4 v0 = (acc[ai][bj][m][0] + b0) * gt, v1 = (acc[ai][bj][m][1] + b1) * gt;
                    *(u32x4*)(YR + ((size_t)(u.pm * 256 + lr) * 1024 + col)) = pack8(v0, v1);
                }
        }
    }
};

struct SchedG1 {
    static constexpr bool GATHER = false;
    const char *A, *Bt; int G, vcu;
    __device__ __forceinline__ bool next(int i, Unit& u) const {
        const int L = i * G + vcu; if (L >= 844) return false;
        int pm, pn;
        if (L < 832) { const int grp = L / 104, w = L % 104; pm = grp * 8 + (w & 7); pn = w >> 3; }
        else { const int j = L - 832; pm = 64 + (j & 3); const int c = j >> 2; pn = c == 2 ? 4 : c; }
        u.pm = pm; u.pn = pn; u.aux = 0; u.a = A + (size_t)pm * 256 * 2048; u.b = Bt + (size_t)pn * 256 * 2048; return true;
    }
    __device__ __forceinline__ unsigned arow(const Unit&, int R) const { return (unsigned)R; }
};
struct SchedS5L {
    static constexpr bool GATHER = false;
    const char *AP, *BTL; int G, vcu;
    __device__ __forceinline__ bool next(int i, Unit& u) const {
        const int L = i * G + vcu; if (L >= 96) return false;
        const int g = L / 3, pm = L % 3;
        u.pm = pm; u.pn = 0; u.aux = g; u.a = AP + ((size_t)(g * SROWS + pm * 256) * SK) * 2; u.b = BTL + (size_t)g * 256 * 512 * 2; return true;
    }
    __device__ __forceinline__ unsigned arow(const Unit&, int R) const { return (unsigned)R; }
};
struct SchedS5Y {
    static constexpr bool GATHER = false;
    const char *AP, *BTY; int G, vcu;
    __device__ __forceinline__ bool next(int i, Unit& u) const {
        const int L = i * G + vcu; if (L >= 128) return false;
        const int g = L >> 2, pm = (L >> 1) & 1, pn = L & 1;
        u.pm = pm; u.pn = pn; u.aux = g; u.a = AP + ((size_t)(g * SROWS + pm * 256) * SK) * 2; u.b = BTY + ((size_t)(g * 512 + pn * 256) * SK) * 2; return true;
    }
    __device__ __forceinline__ unsigned arow(const Unit&, int R) const { return (unsigned)R; }
};
struct SchedPlain {
    static constexpr bool GATHER = false;
    const char *A, *Bt; int nM, nN, K, G, vcu;
    __device__ __forceinline__ bool next(int i, Unit& u) const {
        const int L = i * G + vcu; if (L >= nM * nN) return false;
        const int nig = 8 * nN, grp = L / nig, w = L % nig;
        u.pm = grp * 8 + (w & 7); u.pn = w >> 3; u.aux = 0;
        u.a = A + (size_t)u.pm * 256 * K * 2; u.b = Bt + (size_t)u.pn * 256 * K * 2; return true;
    }
    __device__ __forceinline__ unsigned arow(const Unit&, int R) const { return (unsigned)R; }
};
struct SchedMerge {
    static constexpr bool GATHER = false;
    const char *Z2, *OA, *WSO, *WAO; int G, vcu;
    __device__ __forceinline__ bool next(int i, Unit& u) const {
        const int tile = (i >> 1) * G + vcu; if (tile >= 256) return false;
        const int part = i & 1, grp = tile >> 5, w = tile & 31;
        u.pm = grp * 8 + (w & 7); u.pn = w >> 3; u.aux = part;
        u.a = (part ? OA : Z2) + (size_t)u.pm * 256 * 512 * 2; u.b = (part ? WAO : WSO) + (size_t)u.pn * 256 * 512 * 2; return true;
    }
    __device__ __forceinline__ unsigned arow(const Unit&, int R) const { return (unsigned)R; }
};
template <int NPN, bool GATH>
struct SchedMoe {
    static constexpr bool GATHER = GATH;
    const char *A, *Bt; const int* list; MoeTab tab; int G, vcu;
    __device__ __forceinline__ bool next(int i, Unit& u) const {
        const int L = i * G + vcu; const int total = tab.t[32] * NPN; if (L >= total) return false;
        int e = 0;
        while (e < 31 && tab.t[e + 1] * NPN <= L) ++e;
        const int tb = tab.t[e], nt = tab.t[e + 1] - tb, w = L - tb * NPN;
        const int pn = w / nt, rt = w % nt;
        u.pm = tb + rt; u.pn = pn; u.aux = e;
        if (GATH) { u.a = A; u.b = Bt + ((size_t)e * 2048 + pn * 256) * 2048; }
        else { u.a = A + (size_t)u.pm * 256 * 2048; u.b = Bt + ((size_t)e * 1024 + pn * 256) * 2048; }
        return true;
    }
    __device__ __forceinline__ unsigned arow(const Unit& u, int R) const {
        const int e = u.aux, idx = (u.pm - tab.t[e]) * 256 + R;
        return idx < tab.t[64 + e] ? (unsigned)list[(size_t)e * LCAP + idx] : 0u;
    }
};

struct Args { const void* in[33]; float* out; unsigned char* ws; int ph_lo, ph_hi; };
struct Frame {
    LAS unsigned char* lds; volatile LAS int* MISC;
    int tid, lane, wave, vcu, G;
    unsigned char* ws; const Args* a;
};
#define IN_F(k) ((const float*)args.in[k])
enum { I_X = 0, I_C, I_CTX, I_CCTX, I_LNG, I_LNB, I_WMOD, I_BMOD, I_WIN, I_LRE, I_LIM, I_LSTEP, I_BRE, I_BIM, I_CRE, I_CIM, I_SD, I_WGLU, I_BGLU, I_SINK, I_WSO, I_WAO, I_WO,
       I_LN1G, I_LN1B, I_WR, I_BR, I_WGU, I_BGU, I_WD, I_BD, I_LN2G, I_LN2B };

template <int MAP> __device__ __forceinline__ int dest_row(int n) {
    if (MAP == 1) { return (n >= 512 && n < 1152) ? ((n & ~63) + 2 * (n & 31) + ((n >> 5) & 1)) : n; }
    if (MAP == 2) { const int f = n & 1023, lin = n >> 10; return (f >> 7) * 256 + lin * 128 + (f & 127); }
    return n;
}
template <int MAP> __device__ __forceinline__ void transpose_item(const float* __restrict__ W, int K, int N, bf16_t* __restrict__ WT, LAS float* scr, int item, int lane) {
    const int nkb = K / 64, kb = item % nkb, nb = item / nkb, k0 = 64 * kb, n0 = 64 * nb;
    const int kr = lane >> 4, c4 = (lane & 15) * 4;
    const float* src = W + (size_t)(k0 + kr) * N + n0 + c4;
    f32x4 v[16];
#pragma unroll
    for (int i = 0; i < 16; ++i) v[i] = *(const f32x4*)(src + (size_t)(4 * i) * N);
#pragma unroll
    for (int i = 0; i < 16; ++i) { const int k = 4 * i + kr; *(LAS f32x4*)(scr + k * 64 + (c4 ^ (((k >> 3) & 7) << 2))) = v[i]; }
    const int c = lane & 7;
#pragma unroll
    for (int jj = 0; jj < 8; ++jj) { const int n = (lane >> 3) + 8 * jj; const LAS float* sp = scr + (8 * c) * 64 + (n ^ (c << 2));
        u32x4 o; o.x = cvtpk(sp[0], sp[64]); o.y = cvtpk(sp[128], sp[192]); o.z = cvtpk(sp[256], sp[320]); o.w = cvtpk(sp[384], sp[448]);
        *(u32x4*)(WT + (size_t)dest_row<MAP>(n0 + n) * K + k0 + 8 * c) = o; }
}
struct Cx { float re, im; };
__device__ __forceinline__ Cx cmul(Cx a, Cx b) { return Cx{a.re * b.re - a.im * b.im, a.re * b.im + a.im * b.re}; }
__device__ __forceinline__ Cx apow(float lr, float li, float dt, float n) {
    const float mag = expf(lr * dt * n); const float ang = li * dt * n;
    const float k = rintf(ang * 0.15915494309189535f); float r = fmaf(-k, 6.2831854820251465f, ang); r = fmaf(-k, -1.7484555e-7f, r);
    float s, c; sincosf(r, &s, &c); return Cx{mag * c, mag * s};
}
__device__ __forceinline__ Cx s5coef(float lr, float li, float dt) {
    const Cx a = apow(lr, li, dt, 1.f); const float den = lr * lr + li * li; const float ar1 = a.re - 1.f;
    return Cx{(ar1 * lr + a.im * li) / den, (a.im * lr - ar1 * li) / den};
}

__device__ __forceinline__ void p0_prep(const Args& args, Frame& F) {
    unsigned char* ws = F.ws;
    {
        LAS float* sc = (LAS float*)F.lds; LAS float* red = sc + 5 * 1024;
        const float* c = IN_F(I_C); const float* cc = IN_F(I_CCTX); const float* wm = IN_F(I_WMOD); const float* bm = IN_F(I_BMOD); float* mod = (float*)(ws + WS_MOD);
        for (int idx = F.tid; idx < 5 * 1024; idx += NTHR) { const int j = idx >> 10, k = idx & 1023; const float v = j < 4 ? c[j * 1024 + k] : cc[k]; sc[idx] = v * sigmoidf_(v); }
        __syncthreads();
        for (int slab = (int)blockIdx.x; slab < 256; slab += F.G) {
            const int kq = F.tid / 24, cl = F.tid % 24, col = slab * 24 + cl;
            if (F.tid < 384) {
                float acc[5] = {0.f, 0.f, 0.f, 0.f, 0.f};
#pragma unroll 32
                for (int k = kq * 64; k < kq * 64 + 64; ++k) { const float w = wm[(size_t)k * 6144 + col];
#pragma unroll
                    for (int j = 0; j < 5; ++j) acc[j] += sc[j * 1024 + k] * w; }
#pragma unroll
                for (int j = 0; j < 5; ++j) red[(kq * 5 + j) * 24 + cl] = acc[j];
            }
            __syncthreads();
            if (F.tid < 120) { const int j = F.tid / 24, c2 = F.tid % 24; float s = 0.f;
#pragma unroll
                for (int q = 0; q < 16; ++q) s += red[(q * 5 + j) * 24 + c2];
                mod[j * 6144 + slab * 24 + c2] = s + bm[slab * 24 + c2]; }
            __syncthreads();
        }
        const int gt = F.vcu * NTHR + F.tid;
        if (gt < 1024) { const int pos = gt >> 4, fi = gt & 15; const float inv = exp2f(-(float)fi * (13.287712379549449f / 16.f)); const float ang = (float)pos * inv;
            float s, cs; sincosf(ang, &s, &cs); float* rp = (float*)(ws + WS_ROPE); rp[gt * 2] = cs; rp[gt * 2 + 1] = s; }
    }
    __syncthreads();
    const int gw = F.vcu * NWAVES + F.wave, NGW = F.G * NWAVES;
    {
        const float* lre = IN_F(I_LRE); const float* lim = IN_F(I_LIM); const float* lst = IN_F(I_LSTEP);
        const float* bre = IN_F(I_BRE); const float* bim = IN_F(I_BIM); const float* cre = IN_F(I_CRE); const float* cim = IN_F(I_CIM); const float* sd = IN_F(I_SD);
        bf16_t* BTY = (bf16_t*)(ws + WS_BTY); bf16_t* BTL = (bf16_t*)(ws + WS_BTL);
        LAS float* wl = (LAS float*)F.lds + F.wave * 256;
        const int p = F.lane;
        constexpr int NT_ITEMS = 32 * 63, NE_ITEMS = 32 * 32, NF_ITEMS = 32 * 32;
        for (int it = gw; it < NT_ITEMS + NE_ITEMS + NF_ITEMS; it += NGW) {
            if (it < NT_ITEMS) {
                const int g = it / 63, ds = it % 63 - 31, d = ds < 0 ? -ds : ds;
#pragma unroll
                for (int dir = 0; dir < 2; ++dir) {
                    const float lr = lre[(dir * 32 + g) * 64 + p], li = lim[(dir * 32 + g) * 64 + p], dt = expf(lst[dir * 32 + g]);
                    const Cx w = cmul(apow(lr, li, dt, (float)d), s5coef(lr, li, dt));
                    wl[(dir * 64 + p) * 2] = w.re; wl[(dir * 64 + p) * 2 + 1] = w.im;
                }
                LDS_WAIT(); asm volatile("" ::: "memory");
                const int h = F.lane >> 2, hp0 = (F.lane & 3) * 4;
                float kv[4] = {0.f, 0.f, 0.f, 0.f};
#pragma unroll
                for (int dir = 0; dir < 2; ++dir) {
                    if ((dir == 0 && ds < 0) || (dir == 1 && ds > 0)) continue;
                    const float* cr = cre + ((size_t)(dir * 32 + g) * 16 + h) * 64; const float* ci = cim + ((size_t)(dir * 32 + g) * 16 + h) * 64;
                    const float* br = bre + (size_t)(dir * 32 + g) * 64 * 16 + hp0; const float* bi = bim + (size_t)(dir * 32 + g) * 64 * 16 + hp0;
#pragma unroll 16
                    for (int q = 0; q < 64; ++q) {
                        const float wr_ = wl[(dir * 64 + q) * 2], wi_ = wl[(dir * 64 + q) * 2 + 1];
                        const float c_r = cr[q], c_i = ci[q]; const float xr = c_r * wr_ - c_i * wi_, xi = c_r * wi_ + c_i * wr_;
                        const f32x4 b_r = *(const f32x4*)(br + q * 16), b_i = *(const f32x4*)(bi + q * 16);
#pragma unroll
                        for (int e = 0; e < 4; ++e) kv[e] += xr * b_r[e] - xi * b_i[e];
                    }
                }
                if (ds == 0) {
#pragma unroll
                    for (int e = 0; e < 4; ++e) if (hp0 + e == h) kv[e] += sd[g * 16 + h]; }
                u32x2 w2; w2.x = cvtpk(kv[0], kv[1]); w2.y = cvtpk(kv[2], kv[3]);
                for (int i = (ds > 0 ? d : 0); i < (ds < 0 ? 32 - d : 32); ++i) { const int j = i - ds;
                    *(u32x2*)(BTY + ((size_t)(g * 512 + i * 16 + h) * SK + j * 16 + hp0)) = w2; }
                LDS_WAIT(); asm volatile("" ::: "memory");
            } else if (it < NT_ITEMS + NE_ITEMS) {
                const int e2 = it - NT_ITEMS, g = e2 >> 5, i = e2 & 31;
#pragma unroll
                for (int dir = 0; dir < 2; ++dir) {
                    const float lr = lre[(dir * 32 + g) * 64 + p], li = lim[(dir * 32 + g) * 64 + p], dt = expf(lst[dir * 32 + g]);
                    const Cx a = apow(lr, li, dt, dir == 0 ? (float)(i + 1) : (float)(32 - i));
#pragma unroll
                    for (int h = 0; h < 16; ++h) {
                        const Cx cc = Cx{cre[((size_t)(dir * 32 + g) * 16 + h) * 64 + p], cim[((size_t)(dir * 32 + g) * 16 + h) * 64 + p]};
                        const Cx ev = cmul(cc, a);
                        bf16_t* rowp = BTY + (size_t)(g * 512 + i * 16 + h) * SK + 512 + dir * 128 + p;
                        rowp[0] = (bf16_t)(cvtpk(ev.re, 0.f) & 0xffffu); rowp[64] = (bf16_t)(cvtpk(-ev.im, 0.f) & 0xffffu);
                    }
                }
            } else {
                const int f2 = it - NT_ITEMS - NE_ITEMS, g = f2 >> 5, j = f2 & 31;
#pragma unroll
                for (int dir = 0; dir < 2; ++dir) {
                    const float lr = lre[(dir * 32 + g) * 64 + p], li = lim[(dir * 32 + g) * 64 + p], dt = expf(lst[dir * 32 + g]);
                    const Cx w = cmul(apow(lr, li, dt, dir == 0 ? (float)(31 - j) : (float)j), s5coef(lr, li, dt));
                    const float* br = bre + ((size_t)(dir * 32 + g) * 64 + p) * 16; const float* bi = bim + ((size_t)(dir * 32 + g) * 64 + p) * 16;
                    float fr_[16], fi_[16];
#pragma unroll
                    for (int q4 = 0; q4 < 4; ++q4) { const f32x4 b_r = *(const f32x4*)(br + q4 * 4), b_i = *(const f32x4*)(bi + q4 * 4);
#pragma unroll
                        for (int e = 0; e < 4; ++e) { fr_[q4 * 4 + e] = w.re * b_r[e] - w.im * b_i[e]; fi_[q4 * 4 + e] = w.re * b_i[e] + w.im * b_r[e]; } }
                    bf16_t* r0 = BTL + ((size_t)(g * 256 + dir * 128 + p) * 512 + j * 16); bf16_t* r1 = r0 + (size_t)64 * 512;
                    u32x4 o;
                    o.x = cvtpk(fr_[0], fr_[1]); o.y = cvtpk(fr_[2], fr_[3]); o.z = cvtpk(fr_[4], fr_[5]); o.w = cvtpk(fr_[6], fr_[7]); *(u32x4*)r0 = o;
                    o.x = cvtpk(fr_[8], fr_[9]); o.y = cvtpk(fr_[10], fr_[11]); o.z = cvtpk(fr_[12], fr_[13]); o.w = cvtpk(fr_[14], fr_[15]); *(u32x4*)(r0 + 8) = o;
                    o.x = cvtpk(fi_[0], fi_[1]); o.y = cvtpk(fi_[2], fi_[3]); o.z = cvtpk(fi_[4], fi_[5]); o.w = cvtpk(fi_[6], fi_[7]); *(u32x4*)r1 = o;
                    o.x = cvtpk(fi_[8], fi_[9]); o.y = cvtpk(fi_[10], fi_[11]); o.z = cvtpk(fi_[12], fi_[13]); o.w = cvtpk(fi_[14], fi_[15]); *(u32x4*)(r1 + 8) = o;
                }
            }
        }
    }
    __syncthreads();
    {
        LAS float* scr = (LAS float*)(F.lds + F.wave * 16384);
        constexpr int I0 = 16 * 52, I1 = 8 * 8, I2 = 8 * 16, I3 = 8 * 16, I4 = 16 * 16, I5 = 32 * 16 * 32, I6 = 32 * 16 * 16;
        constexpr int NITEMS = I0 + I1 + I2 + I3 + I4 + I5 + I6;
        const int gwl = (int)blockIdx.x * NWAVES + F.wave;
        for (int it = gwl; it < NITEMS; it += NGW) {
            int r = it;
            if (r < I5) { const int e = r >> 9; transpose_item<2>(IN_F(I_WGU) + (size_t)e * 1024 * 2048, 1024, 2048, (bf16_t*)(ws + WS_WGUT) + (size_t)e * 2048 * 1024, scr, r & 511, F.lane); continue; } r -= I5;
            if (r < I6) { const int e = r >> 8; transpose_item<0>(IN_F(I_WD) + (size_t)e * 1024 * 1024, 1024, 1024, (bf16_t*)(ws + WS_WDT) + (size_t)e * 1024 * 1024, scr, r & 255, F.lane); continue; } r -= I6;
            if (r < I0) { transpose_item<1>(IN_F(I_WIN), 1024, INC, (bf16_t*)(ws + WS_WINT), scr, r, F.lane); continue; } r -= I0;
            if (r < I1) { transpose_item<0>(IN_F(I_WGLU), 512, 512, (bf16_t*)(ws + WS_WGLUT), scr, r, F.lane); continue; } r -= I1;
            if (r < I2) { transpose_item<0>(IN_F(I_WSO), 512, 1024, (bf16_t*)(ws + WS_WSOT), scr, r, F.lane); continue; } r -= I2;
            if (r < I3) { transpose_item<0>(IN_F(I_WAO), 512, 1024, (bf16_t*)(ws + WS_WAOT), scr, r, F.lane); continue; } r -= I3;
            transpose_item<0>(IN_F(I_WO), 1024, 1024, (bf16_t*)(ws + WS_WOT), scr, r, F.lane);
        }
    }
}

__device__ __forceinline__ void p1_lnmod(const Args& args, Frame& F) {
    const float* lg = IN_F(I_LNG); const float* lb = IN_F(I_LNB); const float* mod = (const float*)(F.ws + WS_MOD);
    float* st0 = (float*)(F.ws + WS_ST0); bf16_t* U = (bf16_t*)(F.ws + WS_U);
    const int gw = F.vcu * NWAVES + F.wave, NGW = F.G * NWAVES;
    for (int r = gw; r < MALL; r += NGW) {
        const float* src = r < MTOK ? IN_F(I_X) + (size_t)r * D : IN_F(I_CTX) + (size_t)(r - MTOK) * D;
        const int mj = r < MTOK ? (r >> 12) : 4;
        const f32x4* xr = (const f32x4*)src + F.lane;
        f32x4 v[4]; float s = 0.f;
#pragma unroll
        for (int j = 0; j < 4; ++j) { v[j] = xr[64 * j]; s += (v[j][0] + v[j][1]) + (v[j][2] + v[j][3]); }
        const float mean = wave_sum(s) * (1.f / D); float s2 = 0.f;
#pragma unroll
        for (int j = 0; j < 4; ++j) { v[j] = v[j] - mean; s2 += (v[j][0] * v[j][0] + v[j][1] * v[j][1]) + (v[j][2] * v[j][2] + v[j][3] * v[j][3]); }
        const float rstd = 1.f / sqrtf(wave_sum(s2) * (1.f / D) + LN_EPS);
        if (F.lane == 0) { st0[r * 2] = mean; st0[r * 2 + 1] = rstd; }
        const f32x4* sh = (const f32x4*)(mod + mj * 6144) + F.lane; const f32x4* sc = (const f32x4*)(mod + mj * 6144 + 1024) + F.lane;
        const f32x4* g4 = (const f32x4*)lg + F.lane; const f32x4* b4 = (const f32x4*)lb + F.lane;
        u32x2* o8 = (u32x2*)(U + (size_t)r * D) + F.lane;
#pragma unroll
        for (int j = 0; j < 4; ++j) { const f32x4 h = v[j] * rstd * g4[64 * j] + b4[64 * j]; const f32x4 u = h * (sc[64 * j] + 1.f) + sh[64 * j];
            u32x2 w; w.x = cvtpk(u[0], u[1]); w.y = cvtpk(u[2], u[3]); o8[64 * j] = w; }
    }
}

__device__ __forceinline__ int crow16(int r, int hi) { return (r & 3) + 8 * (r >> 2) + 4 * hi; }
__device__ __forceinline__ void attn_phase(const Args& args, Frame& F) {
    const bf16_t* Q = (const bf16_t*)(F.ws + WS_Q); const bf16_t* KB = (const bf16_t*)(F.ws + WS_KB); const bf16_t* VB = (const bf16_t*)(F.ws + WS_VB);
    bf16_t* OA = (bf16_t*)(F.ws + WS_OATT); const float* sink = IN_F(I_SINK);
    LAS unsigned char* Ks = F.lds; LAS unsigned char* Vt = F.lds + 9216; LAS float* wsf = (LAS float*)(F.lds + 17920) + F.wave * 64;
    const int lane = F.lane, r = lane & 31, hi = lane >> 5, wave = F.wave, tid = F.tid;
    const int key = tid >> 3, ch = tid & 7;
    for (int unit = F.vcu; unit < 256; unit += F.G) {
        const int nb = unit & 31, kvh = (unit >> 5) & 1, b = unit >> 6;
        const int q0 = nb * 128, head = kvh * 4 + (wave >> 1), qs = q0 + (wave & 1) * 64;
        bf16x8 qf[2][4];
#pragma unroll
        for (int g2 = 0; g2 < 2; ++g2)
#pragma unroll
            for (int s = 0; s < 4; ++s) qf[g2][s] = *(const bf16x8*)(Q + ((size_t)(b * SEQ + qs + g2 * 32 + r) * 512 + head * 64 + s * 16 + hi * 8));
        float mrun[2], lrun[2]; f32x16 o[2][2];
#pragma unroll
        for (int g2 = 0; g2 < 2; ++g2) { mrun[g2] = sink[head] * LOG2E; lrun[g2] = hi == 0 ? 1.f : 0.f; o[g2][0] = f32x16{}; o[g2][1] = f32x16{}; }
        int tt = 0;
        u32x4 kreg, vreg;
        { const size_t row = (size_t)(MTOK + b * CTX + key); kreg = *(const u32x4*)(KB + row * 128 + kvh * 64 + ch * 8); vreg = *(const u32x4*)(VB + row * 128 + kvh * 64 + ch * 8); }
        while (tt < 10) {
            __syncthreads();
            *(LAS u32x4*)(Ks + key * 144 + ch * 16) = kreg;
            { LAS unsigned short* vp = (LAS unsigned short*)(Vt + (ch * 8) * 136 + key * 2);
              vp[0 * 68] = (unsigned short)(vreg.x & 0xffffu); vp[1 * 68] = (unsigned short)(vreg.x >> 16); vp[2 * 68] = (unsigned short)(vreg.y & 0xffffu); vp[3 * 68] = (unsigned short)(vreg.y >> 16);
              vp[4 * 68] = (unsigned short)(vreg.z & 0xffffu); vp[5 * 68] = (unsigned short)(vreg.z >> 16); vp[6 * 68] = (unsigned short)(vreg.w & 0xffffu); vp[7 * 68] = (unsigned short)(vreg.w >> 16); }
            __syncthreads();
            const int cur = tt; const bool masked = cur >= 4; const int j0 = q0 - 128 + (cur - 4) * 64;
            int nx = cur + 1;
            while (nx < 10) { const int jn = q0 - 128 + (nx - 4) * 64; if (nx < 4 || (jn >= 0 && jn < SEQ)) break; ++nx; }
            if (nx < 10) { const size_t row = nx < 4 ? (size_t)(MTOK + b * CTX + nx * 64 + key) : (size_t)(b * SEQ + q0 - 128 + (nx - 4) * 64 + key);
                kreg = *(const u32x4*)(KB + row * 128 + kvh * 64 + ch * 8); vreg = *(const u32x4*)(VB + row * 128 + kvh * 64 + ch * 8); }
            tt = nx;
#pragma unroll
            for (int g2 = 0; g2 < 2; ++g2) {
                f32x16 p0 = f32x16{}, p1 = f32x16{};
#pragma unroll
                for (int s = 0; s < 4; ++s) {
                    const bf16x8 kf0 = *(const LAS bf16x8*)(Ks + r * 144 + (s * 16 + hi * 8) * 2), kf1 = *(const LAS bf16x8*)(Ks + (32 + r) * 144 + (s * 16 + hi * 8) * 2);
                    p0 = __builtin_amdgcn_mfma_f32_32x32x16_bf16(kf0, qf[g2][s], p0, 0, 0, 0); p1 = __builtin_amdgcn_mfma_f32_32x32x16_bf16(kf1, qf[g2][s], p1, 0, 0, 0);
                }
                if (masked) { const int qpos = qs + g2 * 32 + r;
#pragma unroll
                    for (int e = 0; e < 16; ++e) { const int d0 = j0 + crow16(e, hi) - qpos; if (d0 > 128 || d0 < -128) p0[e] = -1e30f; const int d1 = d0 + 32; if (d1 > 128 || d1 < -128) p1[e] = -1e30f; } }
                float tm = fmaxf(p0[0], p1[0]);
#pragma unroll
                for (int e = 1; e < 16; ++e) tm = fmaxf(tm, fmaxf(p0[e], p1[e]));
                tm = fmaxf(tm, __shfl_xor(tm, 32));
                const float mn = fmaxf(mrun[g2], tm); const float alpha = __builtin_amdgcn_exp2f(mrun[g2] - mn); mrun[g2] = mn;
                float rs = 0.f;
#pragma unroll
                for (int e = 0; e < 16; ++e) { p0[e] = __builtin_amdgcn_exp2f(p0[e] - mn); p1[e] = __builtin_amdgcn_exp2f(p1[e] - mn); rs += p0[e] + p1[e]; }
                lrun[g2] = lrun[g2] * alpha + rs;
                if (hi == 0) wsf[g2 * 32 + r] = alpha;
#pragma unroll
                for (int e = 0; e < 16; ++e) { const float a = wsf[g2 * 32 + crow16(e, hi)]; o[g2][0][e] *= a; o[g2][1][e] *= a; }
                u32x4 pw[4];
#pragma unroll
                for (int q4 = 0; q4 < 4; ++q4) { pw[0][q4] = cvtpk(p0[2 * q4], p0[2 * q4 + 1]); pw[1][q4] = cvtpk(p0[8 + 2 * q4], p0[8 + 2 * q4 + 1]); pw[2][q4] = cvtpk(p1[2 * q4], p1[2 * q4 + 1]); pw[3][q4] = cvtpk(p1[8 + 2 * q4], p1[8 + 2 * q4 + 1]); }
#pragma unroll
                for (int dh = 0; dh < 2; ++dh)
#pragma unroll
                    for (int s = 0; s < 4; ++s) { const int kb = 16 * (s & 1) + 32 * (s >> 1);
                        const u32x2 lo = *(const LAS u32x2*)(Vt + (dh * 32 + r) * 136 + (kb + 4 * hi) * 2), h2 = *(const LAS u32x2*)(Vt + (dh * 32 + r) * 136 + (kb + 8 + 4 * hi) * 2);
                        const u32x4 vv = {lo.x, lo.y, h2.x, h2.y};
                        o[g2][dh] = __builtin_amdgcn_mfma_f32_32x32x16_bf16(__builtin_bit_cast(bf16x8, pw[s]), __builtin_bit_cast(bf16x8, vv), o[g2][dh], 0, 0, 0); }
            }
        }
#pragma unroll
        for (int g2 = 0; g2 < 2; ++g2) {
            const float lt = lrun[g2] + __shfl_xor(lrun[g2], 32);
            if (hi == 0) wsf[g2 * 32 + r] = 1.f / lt;
#pragma unroll
            for (int e = 0; e < 16; ++e) { const float a = wsf[g2 * 32 + crow16(e, hi)];
                bf16_t* op = OA + ((size_t)(b * SEQ + qs + g2 * 32 + crow16(e, hi)) * 512 + head * 64 + r);
                op[0] = (bf16_t)(cvtpk(o[g2][0][e] * a, 0.f) & 0xffffu); op[32] = (bf16_t)(cvtpk(o[g2][1][e] * a, 0.f) & 0xffffu); }
        }
    }
    __syncthreads();
}

__device__ __forceinline__ void scan_phase(const Args& args, Frame& F) {
    if (F.tid >= 64) return;
    const int gt = F.vcu * 64 + F.tid; if (gt >= NB * SG * 128) return;
    const int q = gt & 127, dir = q >> 6, p = q & 63, g = (gt >> 7) & 31, b = gt >> 12;
    const float* L = (const float*)(F.ws + WS_LBUF) + (size_t)g * SROWS * 256 + dir * 128 + p;
    bf16_t* AP = (bf16_t*)(F.ws + WS_AP) + (size_t)g * SROWS * SK + 512 + dir * 128 + p;
    const float lr = IN_F(I_LRE)[(dir * 32 + g) * 64 + p], li = IN_F(I_LIM)[(dir * 32 + g) * 64 + p], dt = expf(IN_F(I_LSTEP)[dir * 32 + g]);
    const Cx a32 = apow(lr, li, dt, 32.f);
    Cx S = Cx{0.f, 0.f};
    if (dir == 0) {
        for (int cc = 0; cc < 8; ++cc) { const float* lp = L + (size_t)(512 + b * 8 + cc) * 256; const Cx t = cmul(a32, S); S = Cx{t.re + lp[0], t.im + lp[64]}; }
        for (int c = 0; c < 128; ++c) { const int row = b * 128 + c; bf16_t* ap = AP + (size_t)row * SK; ap[0] = (bf16_t)(cvtpk(S.re, 0.f) & 0xffffu); ap[64] = (bf16_t)(cvtpk(S.im, 0.f) & 0xffffu);
            const float* lp = L + (size_t)row * 256; const Cx t = cmul(a32, S); S = Cx{t.re + lp[0], t.im + lp[64]}; }
    } else {
        for (int cc = 7; cc >= 0; --cc) { const float* lp = L + (size_t)(512 + b * 8 + cc) * 256; const Cx t = cmul(a32, S); S = Cx{t.re + lp[0], t.im + lp[64]}; }
        for (int c = 127; c >= 0; --c) { const int row = b * 128 + c; bf16_t* ap = AP + (size_t)row * SK; ap[0] = (bf16_t)(cvtpk(S.re, 0.f) & 0xffffu); ap[64] = (bf16_t)(cvtpk(S.im, 0.f) & 0xffffu);
            const float* lp = L + (size_t)row * 256; const Cx t = cmul(a32, S); S = Cx{t.re + lp[0], t.im + lp[64]}; }
    }
}

constexpr int WTP = 1028;
#define RT_XCHG(dst, src, n, bit) do { const bool up_ = (lane & (bit)) != 0; _Pragma("unroll") for (int i_ = 0; i_ < (n); ++i_) { \
        const float a_ = src[i_], b_ = src[i_ + (n)]; const float send_ = up_ ? a_ : b_; const float keep_ = up_ ? b_ : a_; dst[i_] = keep_ + __shfl_xor(send_, (bit)); } } while (0)
__device__ __forceinline__ void router_phase(const Args& args, Frame& F) {
    unsigned char* ws = F.ws;
    LAS float* wT = (LAS float*)F.lds;
    volatile LAS int* cnt = F.MISC + 128; volatile LAS int* base = F.MISC + 160; volatile LAS int* rinfo = F.MISC + 256;
    LAS float* rgate = (LAS float*)(F.MISC + 512);
    LAS float* lgs = (LAS float*)(F.MISC + 768) + F.wave * 64;
    const float* wr = IN_F(I_WR);
#pragma unroll 4
    for (int r = 0; r < 16; ++r) { const int idx4 = F.tid + NTHR * r, k = idx4 >> 3, e0 = (idx4 & 7) * 4; const f32x4 v = *(const f32x4*)(wr + k * 32 + e0);
        wT[(e0 + 0) * WTP + k] = v[0]; wT[(e0 + 1) * WTP + k] = v[1]; wT[(e0 + 2) * WTP + k] = v[2]; wT[(e0 + 3) * WTP + k] = v[3]; }
    if (F.tid < 32) cnt[F.tid] = 0;
    __syncthreads();
    const float* R1 = (const float*)(ws + WS_R1); float* st1 = (float*)(ws + WS_ST1); bf16_t* XF = (bf16_t*)(ws + WS_XF);
    const float* mod = (const float*)(ws + WS_MOD); const float* l1g = IN_F(I_LN1G); const float* l1b = IN_F(I_LN1B); const float* brt = IN_F(I_BR);
    int* toke = (int*)(ws + WS_TOKE); float* tokg = (float*)(ws + WS_TOKG); int* tokp = (int*)(ws + WS_TOKP);
    const int lane = F.lane;
    const int rows_per_blk = MTOK / F.G;
    const int row_base = F.vcu * rows_per_blk;
    const float bias = brt[lane & 31];
    for (int rl = F.wave * 2; rl < rows_per_blk; rl += NWAVES * 2) {
        f32x2 xv[4][4];
#pragma unroll
        for (int rr = 0; rr < 2; ++rr) {
            const int row = row_base + rl + rr; const int b = row >> 12;
            const f32x4* xr = (const f32x4*)(R1 + (size_t)row * D) + lane;
            f32x4 v[4]; float s = 0.f;
#pragma unroll
            for (int j = 0; j < 4; ++j) { v[j] = xr[64 * j]; s += (v[j][0] + v[j][1]) + (v[j][2] + v[j][3]); }
            const float mean = wave_sum(s) * (1.f / D); float s2 = 0.f;
#pragma unroll
            for (int j = 0; j < 4; ++j) { v[j] = v[j] - mean; s2 += (v[j][0] * v[j][0] + v[j][1] * v[j][1]) + (v[j][2] * v[j][2] + v[j][3] * v[j][3]); }
            const float rstd = 1.f / sqrtf(wave_sum(s2) * (1.f / D) + LN_EPS);
            if (lane == 0) { st1[row * 2] = mean; st1[row * 2 + 1] = rstd; }
            const f32x4* sh = (const f32x4*)(mod + b * 6144 + 3 * 1024) + lane; const f32x4* sc = (const f32x4*)(mod + b * 6144 + 4 * 1024) + lane;
            const f32x4* g4 = (const f32x4*)l1g + lane; const f32x4* b4 = (const f32x4*)l1b + lane;
            u32x2* o8 = (u32x2*)(XF + (size_t)row * D) + lane;
#pragma unroll
            for (int j = 0; j < 4; ++j) { const f32x4 h = v[j] * rstd * g4[64 * j] + b4[64 * j]; const f32x4 u = h * (sc[64 * j] + 1.f) + sh[64 * j];
#pragma unroll
                for (int c = 0; c < 4; ++c) xv[j][c][rr] = u[c];
                u32x2 w; w.x = cvtpk(u[0], u[1]); w.y = cvtpk(u[2], u[3]); o8[64 * j] = w; }
        }
        float v0[64];
#pragma unroll
        for (int e = 0; e < 32; ++e) {
            f32x2 a = {0.f, 0.f};
#pragma unroll
            for (int j = 0; j < 4; ++j) { const f32x4 w = *(const LAS f32x4*)(wT + e * WTP + 256 * j + 4 * lane);
                a += xv[j][0] * w[0]; a += xv[j][1] * w[1]; a += xv[j][2] * w[2]; a += xv[j][3] * w[3]; }
            v0[e] = a[0]; v0[32 + e] = a[1];
        }
        float v1[32], v2[16], v3[8], v4[4], v5[2], v6[1];
        RT_XCHG(v1, v0, 32, 32); RT_XCHG(v2, v1, 16, 16); RT_XCHG(v3, v2, 8, 8); RT_XCHG(v4, v3, 4, 4); RT_XCHG(v5, v4, 2, 2); RT_XCHG(v6, v5, 1, 1);
        lgs[lane] = v6[0] + bias;
        float lg[32];
        { const LAS f32x4* lp = (const LAS f32x4*)(lgs + (lane & 32));
#pragma unroll
          for (int q = 0; q < 8; ++q) { const f32x4 t = lp[q]; lg[4 * q] = t[0]; lg[4 * q + 1] = t[1]; lg[4 * q + 2] = t[2]; lg[4 * q + 3] = t[3]; } }
        int te[4]; float tv[4];
#pragma unroll
        for (int k = 0; k < 4; ++k) {
            float best = -3.0e38f; int bi = 0;
#pragma unroll
            for (int e = 0; e < 32; ++e) { if (lg[e] > best) { best = lg[e]; bi = e; } }
#pragma unroll
            for (int e = 0; e < 32; ++e) { if (e == bi) lg[e] = -3.0e38f; }
            te[k] = bi; tv[k] = best;
        }
        const float e1 = __expf(tv[1] - tv[0]), e2 = __expf(tv[2] - tv[0]), e3 = __expf(tv[3] - tv[0]); const float inv = 1.f / (1.f + e1 + e2 + e3);
        const int k = lane & 31;
        if (k < 4) {
            const int rr = lane >> 5, row = row_base + rl + rr;
            const int e = k == 0 ? te[0] : k == 1 ? te[1] : k == 2 ? te[2] : te[3]; const float gv = k == 0 ? inv : k == 1 ? e1 * inv : k == 2 ? e2 * inv : e3 * inv;
            const int pl = atomicAdd((int*)&cnt[e], 1);
            rinfo[(rl + rr) * 4 + k] = e | (pl << 8); rgate[(rl + rr) * 4 + k] = gv;
            toke[row * 4 + k] = e; tokg[row * 4 + k] = gv;
        }
    }
    __syncthreads();
    if (F.tid < 32) base[F.tid] = (int)atomicAdd((unsigned*)(ws + WS_CTL) + CW_GCNT + F.tid, (unsigned)cnt[F.tid]);
    __syncthreads();
    if (F.tid < rows_per_blk * 4) {
        const int inf = rinfo[F.tid], e = inf & 255, pos = base[e] + (inf >> 8); const int row = row_base + (F.tid >> 2);
        ((int*)(ws + WS_LIST))[(size_t)e * LCAP + pos] = row; ((float*)(ws + WS_LGATE))[(size_t)e * LCAP + pos] = rgate[F.tid]; tokp[row * 4 + (F.tid & 3)] = pos;
    }
    __syncthreads();
}

__device__ __forceinline__ void moe_tab(Frame& F) {
    __syncthreads();
    if (F.tid == 0) { const unsigned* gc = (const unsigned*)(F.ws + WS_CTL) + CW_GCNT; int acc = 0;
        for (int e = 0; e < 32; ++e) { const int c = (int)__hip_atomic_load(gc + e, __ATOMIC_RELAXED, __HIP_MEMORY_SCOPE_AGENT); F.MISC[e] = acc; F.MISC[64 + e] = c; acc += (c + 255) >> 8; }
        F.MISC[32] = acc; }
    __syncthreads();
}

__device__ __forceinline__ void combine_phase(const Args& args, Frame& F) {
    unsigned char* ws = F.ws;
    const float* R1 = (const float*)(ws + WS_R1); const float* st1 = (const float*)(ws + WS_ST1); const bf16_t* YR = (const bf16_t*)(ws + WS_YR);
    const int* toke = (const int*)(ws + WS_TOKE); const int* tokp = (const int*)(ws + WS_TOKP); const float* mod = (const float*)(ws + WS_MOD);
    const float* l1g = IN_F(I_LN1G); const float* l1b = IN_F(I_LN1B); const float* l2g = IN_F(I_LN2G); const float* l2b = IN_F(I_LN2B);
    const int lane = F.lane; const int gw = F.vcu * NWAVES + F.wave, NGW = F.G * NWAVES;
    for (int row = gw; row < MTOK; row += NGW) {
        const int b = row >> 12; const float mean1 = st1[row * 2], rstd1 = st1[row * 2 + 1];
        f32x4 ff[4] = {f32x4{}, f32x4{}, f32x4{}, f32x4{}};
#pragma unroll
        for (int k = 0; k < 4; ++k) { const int e = toke[row * 4 + k], pos = tokp[row * 4 + k]; const size_t hr = (size_t)F.MISC[e] * 256 + pos;
            const u32x2* yp = (const u32x2*)(YR + hr * 1024) + lane;
#pragma unroll
            for (int j = 0; j < 4; ++j) { const u32x2 w = yp[64 * j]; ff[j][0] += bflo(w.x); ff[j][1] += bfhi(w.x); ff[j][2] += bflo(w.y); ff[j][3] += bfhi(w.y); } }
        const f32x4* xr = (const f32x4*)(R1 + (size_t)row * D) + lane; const f32x4* g2 = (const f32x4*)(mod + b * 6144 + 5 * 1024) + lane;
        const f32x4* g4 = (const f32x4*)l1g + lane; const f32x4* b4 = (const f32x4*)l1b + lane;
        f32x4 v[4]; float s = 0.f;
#pragma unroll
        for (int j = 0; j < 4; ++j) { const f32x4 h = (xr[64 * j] - mean1) * rstd1 * g4[64 * j] + b4[64 * j]; v[j] = h * DN_ALPHA + g2[64 * j] * ff[j]; s += (v[j][0] + v[j][1]) + (v[j][2] + v[j][3]); }
        const float mean = wave_sum(s) * (1.f / D); float s2 = 0.f;
#pragma unroll
        for (int j = 0; j < 4; ++j) { v[j] = v[j] - mean; s2 += (v[j][0] * v[j][0] + v[j][1] * v[j][1]) + (v[j][2] * v[j][2] + v[j][3] * v[j][3]); }
        const float rstd = 1.f / sqrtf(wave_sum(s2) * (1.f / D) + LN_EPS);
        const f32x4* og = (const f32x4*)l2g + lane; const f32x4* ob = (const f32x4*)l2b + lane; f32x4* op = (f32x4*)(args.out + (size_t)row * D) + lane;
#pragma unroll
        for (int j = 0; j < 4; ++j) op[64 * j] = v[j] * rstd * og[64 * j] + ob[64 * j];
    }
}


#define XB_TMO      128
#define XB_XCNT(j)  (256  + 64 * (j))
#define XB_XSUB(j)  (1280 + 64 * (j))
#define XB_XGEN(j)  (2304 + 64 * (j))
#define XB_TOP      3328
#define XB_TOPGEN   3392
#define XCD_BAR_WORDS 3456
#define XB_SPIN_CAP (1u << 20)
__device__ __forceinline__ unsigned xb_ld(unsigned* p)              { return __hip_atomic_load(p, __ATOMIC_RELAXED, __HIP_MEMORY_SCOPE_AGENT); }
__device__ __forceinline__ unsigned xb_add(unsigned* p, unsigned v) { return __hip_atomic_fetch_add(p, v, __ATOMIC_RELAXED, __HIP_MEMORY_SCOPE_AGENT); }
__device__ __forceinline__ unsigned xb_xcc_id() { return (unsigned)__builtin_amdgcn_s_getreg((3 << 11) | 20) & 0xFu; }
#define XB_SPIN(cond, bar) do { unsigned _sp = 0; while (cond) { __builtin_amdgcn_s_sleep(1); \
    if ((++_sp & 255u) == 0u) { if (xb_ld(&(bar)[XB_TMO])) break; if (_sp > XB_SPIN_CAP) { atomicAdd(&(bar)[XB_TMO], 1u); break; } } } } while (0)
struct XcdBarrier { unsigned* bar; unsigned x; volatile LAS unsigned* st; };
__device__ __forceinline__ XcdBarrier xcd_barrier_post(unsigned* bar, volatile LAS unsigned* st) {
    XcdBarrier b; b.bar = bar; b.x = xb_xcc_id(); b.st = st;
    if (threadIdx.x == 0) (void)xb_add(&bar[XB_XCNT(b.x)], 1u);
    return b;
}
__device__ __forceinline__ void xcd_barrier_complete(unsigned* bar, unsigned x, unsigned& nloc, unsigned& nx) {
    const unsigned G = gridDim.x * gridDim.y * gridDim.z;
    unsigned sum, cnt, mine, sp = 0u;
    for (;;) {
        sum = 0u; cnt = 0u; mine = 0u;
#pragma unroll
        for (unsigned j = 0; j < 16; ++j) { const unsigned c = xb_ld(&bar[XB_XCNT(j)]); sum += c; cnt += (c > 0u) ? 1u : 0u; mine = (j == x) ? c : mine; }
        if (sum == G) break;
        __builtin_amdgcn_s_sleep(1);
        if ((++sp & 255u) == 0u) { if (xb_ld(&bar[XB_TMO])) break; if (sp > XB_SPIN_CAP) { atomicAdd(&bar[XB_TMO], 1u); break; } }
    }
    nloc = mine > 0u ? mine : 1u; nx = cnt > 0u ? cnt : 1u;
}
__device__ __forceinline__ void xcd_barrier(const XcdBarrier& b) {
    asm volatile("s_waitcnt vmcnt(0)" ::: "memory");
    __syncthreads();
    if (threadIdx.x == 0) {
        unsigned* bar = b.bar;
        __builtin_amdgcn_s_waitcnt(0);
        unsigned nloc = b.st[0], nx = b.st[1];
        if (nloc == 0u) { xcd_barrier_complete(bar, b.x, nloc, nx); b.st[0] = nloc; b.st[1] = nx; }
        const unsigned old = xb_add(&bar[XB_XSUB(b.x)], 1u);
        const unsigned gen = old / nloc;
        if (old + 1u == (gen + 1u) * nloc) {
            __builtin_amdgcn_fence(__ATOMIC_RELEASE, "agent");
            asm volatile("s_waitcnt vmcnt(0)" ::: "memory");
            const unsigned og = xb_add(&bar[XB_TOP], 1u);
            const unsigned tg = og / nx;
            if (og + 1u == (tg + 1u) * nx) xb_add(&bar[XB_TOPGEN], 1u);
            else XB_SPIN(xb_ld(&bar[XB_TOPGEN]) == tg, bar);
            __builtin_amdgcn_fence(__ATOMIC_ACQUIRE, "agent");
            xb_add(&bar[XB_XGEN(b.x)], 1u);
            asm volatile("s_waitcnt vmcnt(0)" ::: "memory");
        } else {
            XB_SPIN(xb_ld(&bar[XB_XGEN(b.x)]) == gen, bar);
            __builtin_amdgcn_fence(__ATOMIC_ACQUIRE, "agent");
            asm volatile("s_waitcnt vmcnt(0)" ::: "memory");
        }
    }
    __syncthreads();
}

constexpr int N_PHASES = 14;
__global__ void __launch_bounds__(NTHR, 2) fwd_kernel(Args args) {
    extern __shared__ __attribute__((aligned(16))) unsigned char lds_raw[];
    Frame F;
    F.lds = (LAS unsigned char*)lds_raw; F.MISC = (volatile LAS int*)(F.lds + MISC_OFF);
    F.tid = threadIdx.x; F.lane = F.tid & 63; F.wave = __builtin_amdgcn_readfirstlane(F.tid >> 6);
    F.G = gridDim.x; { const int bx = blockIdx.x; F.vcu = (F.G % 8 == 0) ? (bx % 8) * (F.G / 8) + bx / 8 : bx; }
    F.ws = args.ws; F.a = &args;
    unsigned char* ws = args.ws;
    const int lo = args.ph_lo, hi = args.ph_hi;
#define IN(k) (lo <= (k) && (k) < hi)
#if MK_MULTI
#define GRID_BAR(k) do { } while (0)
#else
    if (F.tid < 2) F.MISC[2000 + F.tid] = 0;
    __syncthreads();
    const XcdBarrier xbar = xcd_barrier_post((unsigned*)(ws + WS_CTL) + CW_BAR, (volatile LAS unsigned*)(F.MISC + 2000));
#define GRID_BAR(k) do { if (IN((k) + 1)) xcd_barrier(xbar); } while (0)
#endif
    if (IN(0)) { p0_prep(args, F); GRID_BAR(0); }
    if (IN(1)) { p1_lnmod(args, F); GRID_BAR(1); }
    if (IN(2)) {
        SchedG1 S{(const char*)(ws + WS_U), (const char*)(ws + WS_WINT), F.G, F.vcu};
        EpiG1 E{(bf16_t*)(ws + WS_AP), (bf16_t*)(ws + WS_Q), (bf16_t*)(ws + WS_KB), (bf16_t*)(ws + WS_VB), (bf16_t*)(ws + WS_SGB), (bf16_t*)(ws + WS_SAB), (const float*)(ws + WS_ROPE)};
        pg8::gemm_phase<EpiG1, SchedG1, true>(F.lds, 1024, 2048u, S, E);
        GRID_BAR(2);
    }
    if (IN(3)) { attn_phase(args, F); }
    if (IN(4)) {
        SchedS5L S{(const char*)(ws + WS_AP), (const char*)(ws + WS_BTL), F.G, F.vcu};
        EpiS5L E{(float*)(ws + WS_LBUF)};
        pg8::gemm_phase<EpiS5L, SchedS5L, true>(F.lds, 512, (unsigned)(SK * 2), S, E);
        GRID_BAR(4);
    }
    if (IN(5)) { scan_phase(args, F); GRID_BAR(5); }
    if (IN(6)) {
        SchedS5Y S{(const char*)(ws + WS_AP), (const char*)(ws + WS_BTY), F.G, F.vcu};
        EpiS5Y E{(bf16_t*)(ws + WS_Z)};
        pg8::gemm_phase<EpiS5Y, SchedS5Y, true>(F.lds, 768, (unsigned)(SK * 2), S, E);
        GRID_BAR(6);
    }
    if (IN(7)) {
        SchedPlain S{(const char*)(ws + WS_Z), (const char*)(ws + WS_WGLUT), 64, 2, 512, F.G, F.vcu};
        EpiGLU E{(const bf16_t*)(ws + WS_Z), (bf16_t*)(ws + WS_Z2), IN_F(I_BGLU)};
        pg8::gemm_phase<EpiGLU, SchedPlain, true>(F.lds, 512, 1024u, S, E);
        GRID_BAR(7);
    }
    if (IN(8)) {
        SchedMerge S{(const char*)(ws + WS_Z2), (const char*)(ws + WS_OATT), (const char*)(ws + WS_WSOT), (const char*)(ws + WS_WAOT), F.G, F.vcu};
        EpiMerge E{(const bf16_t*)(ws + WS_SGB), (const bf16_t*)(ws + WS_SAB), (float*)(ws + WS_TMP), (bf16_t*)(ws + WS_MB)};
        pg8::gemm_phase<EpiMerge, SchedMerge, true>(F.lds, 512, 1024u, S, E);
        GRID_BAR(8);
    }
    if (IN(9)) {
        SchedPlain S{(const char*)(ws + WS_MB), (const char*)(ws + WS_WOT), 64, 4, 1024, F.G, F.vcu};
        EpiWO E{IN_F(I_X), (const float*)(ws + WS_ST0), IN_F(I_LNG), IN_F(I_LNB), (const float*)(ws + WS_MOD), (float*)(ws + WS_R1)};
        pg8::gemm_phase<EpiWO, SchedPlain, true>(F.lds, 1024, 2048u, S, E);
        GRID_BAR(9);
    }
    if (IN(10)) { router_phase(args, F); GRID_BAR(10); }
    if (IN(11)) {
        moe_tab(F);
        SchedMoe<8, true> S{(const char*)(ws + WS_XF), (const char*)(ws + WS_WGUT), (const int*)(ws + WS_LIST), MoeTab{F.MISC}, F.G, F.vcu};
        EpiMoe1 E{(bf16_t*)(ws + WS_H), IN_F(I_BGU)};
        pg8::gemm_phase<EpiMoe1, SchedMoe<8, true>, true>(F.lds, 1024, 2048u, S, E);
        GRID_BAR(11);
    }
    if (IN(12)) {
        moe_tab(F);
        SchedMoe<4, false> S{(const char*)(ws + WS_H), (const char*)(ws + WS_WDT), (const int*)(ws + WS_LIST), MoeTab{F.MISC}, F.G, F.vcu};
        EpiMoe2 E{(bf16_t*)(ws + WS_YR), IN_F(I_BD), (const float*)(ws + WS_LGATE), MoeTab{F.MISC}};
        pg8::gemm_phase<EpiMoe2, SchedMoe<4, false>, true>(F.lds, 1024, 2048u, S, E);
        GRID_BAR(12);
    }
    if (IN(13)) { moe_tab(F); combine_phase(args, F); }
#undef IN
#undef GRID_BAR
}

extern "C" void kernel_launch(void* const* d_in, const int* in_sizes, int n_in, void* d_out, int out_size, void* d_ws, size_t ws_size, hipStream_t stream) {
    static int grid = 0;
    if (grid == 0) {
        if (n_in != 33 || in_sizes[0] != MTOK * D || out_size != MTOK * D || ws_size < WS_END) { fprintf(stderr, "kernel_launch: unexpected shapes (n_in %d, ws %zu)\n", n_in, ws_size); grid = -1; return; }
        int dev = 0, cus = 0, per_cu = 0;
        if (hipGetDevice(&dev) != hipSuccess || hipDeviceGetAttribute(&cus, hipDeviceAttributeMultiprocessorCount, dev) != hipSuccess) { grid = -1; return; }
        if (hipFuncSetAttribute((const void*)fwd_kernel, hipFuncAttributeMaxDynamicSharedMemorySize, LDS_BYTES) != hipSuccess) { fprintf(stderr, "kernel_launch: hipFuncSetAttribute failed\n"); grid = -1; return; }
        if (hipOccupancyMaxActiveBlocksPerMultiprocessor(&per_cu, (const void*)fwd_kernel, NTHR, LDS_BYTES) != hipSuccess || per_cu < 1) { fprintf(stderr, "kernel_launch: occupancy query says %d\n", per_cu); (void)hipGetLastError(); grid = -1; return; }
        if (cus < 256) { fprintf(stderr, "kernel_launch: needs 256 CUs, device has %d\n", cus); grid = -1; return; }
        grid = 256;
    }
    if (grid < 0) return;
    (void)hipMemsetAsync((char*)d_ws + WS_CTL, 0, CTL_BYTES, stream);
    Args a{};
    for (int i = 0; i < 33; ++i) a.in[i] = d_in[i];
    a.out = (float*)d_out; a.ws = (unsigned char*)d_ws;
#if MK_MULTI
    for (int p = 0; p < N_PHASES; ++p) { a.ph_lo = p; a.ph_hi = p + 1; hipLaunchKernelGGL(fwd_kernel, dim3(grid), dim3(NTHR), LDS_BYTES, stream, a); }
#else
    a.ph_lo = 0; a.ph_hi = N_PHASES;
    void* kargs[] = {&a};
    hipError_t e = hipLaunchCooperativeKernel((const void*)fwd_kernel, dim3(grid), dim3(NTHR), kargs, LDS_BYTES, stream);
    if (e != hipSuccess) fprintf(stderr, "kernel_launch: cooperative launch failed: %s\n", hipGetErrorString(e));
#endif
}
```
